# Optimizing an MI355X kernel written in HIP

```python
import math
import jax, jax.numpy as jnp
from jax import lax
import numpy as np

D_MODEL = 1024
BATCH = 2
SEQ = 8192
DEPTH = 4

D_MIX = D_MODEL
POOL_WIDTH = 256
POOL_WINDOWS = (2, 4, 8, 16)
POOL_GROUP = POOL_WIDTH // len(POOL_WINDOWS)
NSA_HEADS = 8
HEAD_DIM = 64
NSA_WIDTH = NSA_HEADS * HEAD_DIM
NSA_KV_HEADS = 2
NSA_REP = NSA_HEADS // NSA_KV_HEADS
KV_WIDTH = NSA_KV_HEADS * HEAD_DIM
CMP_BLOCK = 32
CMP_STRIDE = 16
CMP_HIDDEN = 128
SLC_BLOCK = 64
SLC_TOP_N = 16
WINDOW = 512
Q_BLOCK = 128
ROPE_THETA = 10000.0
FORCE_BONUS = 1e4
NEG_INF = -1e30
SSM_WIDTH = 256
SSM_GROUP = 16
SSM_GROUPS = SSM_WIDTH // SSM_GROUP
SSM_STATE = 64
DT_MIN = 1e-3
DT_MAX = 1e-1
D_FF = 2816
LN_EPS = 1e-5
ALPHA = (2.0 * DEPTH) ** 0.25
BETA = (8.0 * DEPTH) ** -0.25
IN_COLS = POOL_WIDTH + NSA_WIDTH + 6 * KV_WIDTH + 3 * NSA_HEADS + SSM_WIDTH
SPLITS = (POOL_WIDTH,
          POOL_WIDTH + NSA_WIDTH,
          POOL_WIDTH + NSA_WIDTH + 6 * KV_WIDTH,
          POOL_WIDTH + NSA_WIDTH + 6 * KV_WIDTH + 3 * NSA_HEADS)

kernel_name = 'hybrid_pool_nsa_s5_macaron_deepnorm'


def layer_norm(x, g, b):
    xf = x.astype(jnp.float32)
    mu = jnp.mean(xf, axis=-1, keepdims=True)
    var = jnp.mean(jnp.square(xf - mu), axis=-1, keepdims=True)
    return ((xf - mu) * lax.rsqrt(var + LN_EPS) * g + b).astype(x.dtype)


def swiglu(x, w_in, w_out):
    gate, up = jnp.split(x @ w_in, 2, axis=-1)
    return (jax.nn.silu(gate) * up) @ w_out


def rope_tables(seq):
    inv = 1.0 / (ROPE_THETA ** (jnp.arange(0, HEAD_DIM, 2, dtype=jnp.float32) / HEAD_DIM))
    ang = jnp.arange(seq, dtype=jnp.float32)[:, None] * inv[None, :]
    return jnp.cos(ang), jnp.sin(ang)


def apply_rope(x, cos, sin):
    x1, x2 = jnp.split(x, 2, axis=-1)
    c = cos.astype(x.dtype)
    s = sin.astype(x.dtype)
    return jnp.concatenate([x1 * c - x2 * s, x2 * c + x1 * s], axis=-1)


def pool_mixer(u, w_pool, scale):
    bsz, seq, _ = u.shape
    uf = u.astype(jnp.float32)
    maxw = POOL_WINDOWS[-1]
    csum = jnp.pad(jnp.cumsum(uf, axis=1), ((0, 0), (maxw, 0), (0, 0)))
    t = jnp.arange(seq, dtype=jnp.float32)[None, :, None]
    outs = []
    for gidx, w in enumerate(POOL_WINDOWS):
        sl = slice(gidx * POOL_GROUP, (gidx + 1) * POOL_GROUP)
        tot = csum[:, maxw:, sl] - csum[:, maxw - w:maxw - w + seq, sl]
        outs.append(tot / jnp.minimum(t + 1.0, float(w)) - uf[..., sl])
    pooled = jnp.stack(outs, axis=2).astype(u.dtype)
    mixed = jnp.einsum('bsgc,gcd->bsgd', pooled, w_pool)
    return mixed.reshape(bsz, seq, POOL_WIDTH) * scale


def nsa_mixer(q, k_cmp, v_cmp, k_slc, v_slc, k_win, v_win, gates,
              pe_k, pe_v, ck_w1, ck_w2, cv_w1, cv_w2):
    bsz, _, seq, _ = q.shape
    n_cmp = (seq - CMP_BLOCK) // CMP_STRIDE + 1
    n_slc = seq // SLC_BLOCK
    n_sel = min(SLC_TOP_N, n_slc)
    n_qb = seq // Q_BLOCK
    scale = HEAD_DIM ** -0.5

    cidx = jnp.arange(n_cmp)[:, None] * CMP_STRIDE + jnp.arange(CMP_BLOCK)[None, :]
    cmp_start = cidx[:, 0]
    cmp_end = cidx[:, -1]

    def compress(k, pe, w1, w2):
        kb = (k[:, :, cidx] + pe).reshape(bsz, NSA_KV_HEADS, n_cmp, CMP_BLOCK * HEAD_DIM)
        return jax.nn.gelu(kb @ w1) @ w2

    kc = compress(k_cmp, pe_k, ck_w1, ck_w2)
    vc = compress(v_cmp, pe_v, cv_w1, cv_w2)

    slc_start = jnp.arange(n_slc) * SLC_BLOCK
    overlap = ((cmp_start[:, None] < slc_start[None, :] + SLC_BLOCK)
               & (cmp_end[:, None] >= slc_start[None, :])).astype(jnp.float32)

    ks_blocks = k_slc.reshape(bsz, NSA_KV_HEADS, n_slc, SLC_BLOCK, HEAD_DIM)
    vs_blocks = v_slc.reshape(bsz, NSA_KV_HEADS, n_slc, SLC_BLOCK, HEAD_DIM)
    pad = ((0, 0), (0, 0), (WINDOW, 0), (0, 0))
    kw_pad = jnp.pad(k_win, pad)
    vw_pad = jnp.pad(v_win, pad)
    bi = jnp.arange(bsz)[:, None, None, None]
    gi = jnp.arange(NSA_KV_HEADS)[None, :, None, None]
    blk_ids = jnp.arange(n_slc)
    in_blk = jnp.arange(SLC_BLOCK)
    win_off = jnp.arange(WINDOW + Q_BLOCK)

    def masked_softmax(s, mask):
        s = jnp.where(mask, s.astype(jnp.float32) * scale, NEG_INF)
        return jnp.where(mask, jax.nn.softmax(s, axis=-1), 0.0)

    def one_block(args):
        qb, gb, q0 = args
        tq = q0 + jnp.arange(Q_BLOCK)
        valid_c = cmp_end[None, :] <= tq[:, None]
        p_c = masked_softmax(jnp.einsum('bgrqd,bgcd->bgrqc', qb, kc), valid_c)
        o_cmp = jnp.einsum('bgrqc,bgcd->bgrqd', p_c.astype(vc.dtype), vc)
        imp = jnp.einsum('bgrqc,cj->bgqj', p_c, overlap)
        cur = tq // SLC_BLOCK
        forced = ((blk_ids[None, :] == 0) | (blk_ids[None, :] == cur[:, None])
                  | (blk_ids[None, :] == cur[:, None] - 1))
        imp = jnp.where(forced, imp + FORCE_BONUS, imp)
        imp = jnp.where(slc_start[None, :] <= tq[:, None], imp, NEG_INF)
        _, sel = lax.top_k(imp, n_sel)
        ks = ks_blocks[bi, gi, sel].reshape(bsz, NSA_KV_HEADS, Q_BLOCK, n_sel * SLC_BLOCK, HEAD_DIM)
        vs = vs_blocks[bi, gi, sel].reshape(bsz, NSA_KV_HEADS, Q_BLOCK, n_sel * SLC_BLOCK, HEAD_DIM)
        kpos = (sel[..., None] * SLC_BLOCK + in_blk).reshape(bsz, NSA_KV_HEADS, Q_BLOCK, n_sel * SLC_BLOCK)
        valid_s = (kpos <= tq[None, None, :, None])[:, :, None]
        p_s = masked_softmax(jnp.einsum('bgrqd,bgqkd->bgrqk', qb, ks), valid_s)
        o_slc = jnp.einsum('bgrqk,bgqkd->bgrqd', p_s.astype(vs.dtype), vs)
        kw = lax.dynamic_slice_in_dim(kw_pad, q0, WINDOW + Q_BLOCK, axis=2)
        vw = lax.dynamic_slice_in_dim(vw_pad, q0, WINDOW + Q_BLOCK, axis=2)
        kwpos = q0 - WINDOW + win_off
        dist = tq[:, None] - kwpos[None, :]
        valid_w = (dist >= 0) & (dist < WINDOW) & (kwpos[None, :] >= 0)
        p_w = masked_softmax(jnp.einsum('bgrqd,bgkd->bgrqk', qb, kw), valid_w)
        o_win = jnp.einsum('bgrqk,bgkd->bgrqd', p_w.astype(vw.dtype), vw)
        return gb[..., 0:1] * o_cmp + gb[..., 1:2] * o_slc + gb[..., 2:3] * o_win

    q_blocks = jnp.moveaxis(q.reshape(bsz, NSA_KV_HEADS, NSA_REP, n_qb, Q_BLOCK, HEAD_DIM), 3, 0)
    g_blocks = jnp.moveaxis(gates.reshape(bsz, NSA_KV_HEADS, NSA_REP, n_qb, Q_BLOCK, 3), 3, 0)
    starts = jnp.arange(n_qb, dtype=jnp.int32) * Q_BLOCK
    out = lax.map(one_block, (q_blocks, g_blocks, starts))
    out = jnp.moveaxis(out, 0, 3).reshape(bsz, NSA_HEADS, seq, HEAD_DIM)
    return out.transpose(0, 2, 1, 3).reshape(bsz, seq, NSA_WIDTH)


def s5_mixer(u, lam_re, lam_im, log_dt, b_re, b_im, c_re, c_im, d_skip, glu_w, glu_b):
    bsz, seq, _ = u.shape
    uf = u.astype(jnp.float32).reshape(bsz, seq, SSM_GROUPS, SSM_GROUP)
    dt = jnp.exp(log_dt.astype(jnp.float32))[:, None]
    lr = lam_re.astype(jnp.float32)
    li = lam_im.astype(jnp.float32)
    mag = jnp.exp(lr * dt)
    ar = mag * jnp.cos(li * dt)
    ai = mag * jnp.sin(li * dt)
    den = lr * lr + li * li
    fr = ((ar - 1.0) * lr + ai * li) / den
    fi = (ai * lr - (ar - 1.0) * li) / den
    br = b_re.astype(jnp.float32)
    bim = b_im.astype(jnp.float32)
    bbr = fr[..., None] * br - fi[..., None] * bim
    bbi = fr[..., None] * bim + fi[..., None] * br
    xr = jnp.einsum('bsgc,gpc->bsgp', uf, bbr)
    xi = jnp.einsum('bsgc,gpc->bsgp', uf, bbi)
    a_r = jnp.broadcast_to(ar, xr.shape)
    a_i = jnp.broadcast_to(ai, xr.shape)

    def combine(e1, e2):
        a1r, a1i, b1r, b1i = e1
        a2r, a2i, b2r, b2i = e2
        return (a2r * a1r - a2i * a1i, a2r * a1i + a2i * a1r,
                a2r * b1r - a2i * b1i + b2r, a2r * b1i + a2i * b1r + b2i)

    _, _, hr, hi = lax.associative_scan(combine, (a_r, a_i, xr, xi), axis=1)
    y = (jnp.einsum('bsgp,gcp->bsgc', hr, c_re.astype(jnp.float32))
         - jnp.einsum('bsgp,gcp->bsgc', hi, c_im.astype(jnp.float32))
         + d_skip.astype(jnp.float32) * uf)
    y = jax.nn.gelu(y.reshape(bsz, seq, SSM_WIDTH)).astype(u.dtype)
    return y * jax.nn.sigmoid(y @ glu_w + glu_b)


def hybrid_mixer(h, cos, sin, w_in, w_out, pool_w, pool_scale,
                 pe_k, pe_v, ck_w1, ck_w2, cv_w1, cv_w2,
                 lam_re, lam_im, log_dt, b_re, b_im, c_re, c_im, d_skip, glu_w, glu_b):
    bsz, seq, _ = h.shape
    z = h @ w_in
    u_pool, q, kv, g, u_ssm = jnp.split(z, SPLITS, axis=-1)
    q = apply_rope(q.reshape(bsz, seq, NSA_HEADS, HEAD_DIM).transpose(0, 2, 1, 3), cos, sin)
    kv = kv.reshape(bsz, seq, 6, NSA_KV_HEADS, HEAD_DIM).transpose(2, 0, 3, 1, 4)
    k_cmp = apply_rope(kv[0], cos, sin)
    k_slc = apply_rope(kv[2], cos, sin)
    k_win = apply_rope(kv[4], cos, sin)
    gates = jax.nn.sigmoid(g).reshape(bsz, seq, NSA_HEADS, 3).transpose(0, 2, 1, 3)
    o_pool = pool_mixer(u_pool, pool_w, pool_scale)
    o_nsa = nsa_mixer(q, k_cmp, kv[1], k_slc, kv[3], k_win, kv[5], gates,
                      pe_k, pe_v, ck_w1, ck_w2, cv_w1, cv_w2)
    o_ssm = s5_mixer(u_ssm, lam_re, lam_im, log_dt, b_re, b_im, c_re, c_im, d_skip, glu_w, glu_b)
    return jnp.concatenate([o_pool, o_nsa.astype(o_pool.dtype), o_ssm.astype(o_pool.dtype)], axis=-1) @ w_out


def setup_inputs(seed: int = 0) -> dict:
    key = jax.random.key(seed)
    ks = jax.random.split(key, 32)
    nrm = lambda k, shape, s: jax.random.normal(k, shape, jnp.float32) * s
    L = DEPTH
    n_idx = jnp.arange(SSM_STATE, dtype=jnp.float32)
    log_dt = (math.log(DT_MIN) + jax.random.uniform(ks[20], (L, SSM_GROUPS), jnp.float32)
              * (math.log(DT_MAX) - math.log(DT_MIN)))
    return {
        'x': nrm(ks[0], (BATCH, SEQ, D_MODEL), 1.0),
        'ln_g': 1.0 + nrm(ks[1], (L, 3, D_MODEL), 0.05),
        'ln_b': nrm(ks[2], (L, 3, D_MODEL), 0.02),
        'ffn1_in': nrm(ks[3], (L, D_MODEL, 2 * D_FF), D_MODEL ** -0.5),
        'ffn1_out': nrm(ks[4], (L, D_FF, D_MODEL), BETA * D_FF ** -0.5),
        'ffn2_in': nrm(ks[5], (L, D_MODEL, 2 * D_FF), D_MODEL ** -0.5),
        'ffn2_out': nrm(ks[6], (L, D_FF, D_MODEL), BETA * D_FF ** -0.5),
        'w_in': nrm(ks[7], (L, D_MODEL, IN_COLS), D_MODEL ** -0.5),
        'w_out': nrm(ks[8], (L, D_MIX, D_MODEL), BETA * D_MIX ** -0.5),
        'pool_w': nrm(ks[9], (L, len(POOL_WINDOWS), POOL_GROUP, POOL_GROUP), POOL_GROUP ** -0.5),
        'pool_scale': 1.0 + nrm(ks[10], (L, POOL_WIDTH), 0.1),
        'cmp_pe_k': nrm(ks[11], (L, CMP_BLOCK, HEAD_DIM), 0.1),
        'cmp_pe_v': nrm(ks[12], (L, CMP_BLOCK, HEAD_DIM), 0.1),
        'cmp_k_w1': nrm(ks[13], (L, CMP_BLOCK * HEAD_DIM, CMP_HIDDEN), (CMP_BLOCK * HEAD_DIM) ** -0.5),
        'cmp_k_w2': nrm(ks[14], (L, CMP_HIDDEN, HEAD_DIM), CMP_HIDDEN ** -0.5),
        'cmp_v_w1': nrm(ks[15], (L, CMP_BLOCK * HEAD_DIM, CMP_HIDDEN), (CMP_BLOCK * HEAD_DIM) ** -0.5),
        'cmp_v_w2': nrm(ks[16], (L, CMP_HIDDEN, HEAD_DIM), CMP_HIDDEN ** -0.5),
        'ssm_lam_re': -0.5 + nrm(ks[17], (L, SSM_GROUPS, SSM_STATE), 0.01),
        'ssm_lam_im': math.pi * n_idx + nrm(ks[18], (L, SSM_GROUPS, SSM_STATE), 0.01),
        'ssm_log_dt': log_dt,
        'ssm_b_re': nrm(ks[21], (L, SSM_GROUPS, SSM_STATE, SSM_GROUP), (2.0 * SSM_GROUP) ** -0.5),
        'ssm_b_im': nrm(ks[22], (L, SSM_GROUPS, SSM_STATE, SSM_GROUP), (2.0 * SSM_GROUP) ** -0.5),
        'ssm_c_re': nrm(ks[23], (L, SSM_GROUPS, SSM_GROUP, SSM_STATE), SSM_STATE ** -0.5),
        'ssm_c_im': nrm(ks[24], (L, SSM_GROUPS, SSM_GROUP, SSM_STATE), SSM_STATE ** -0.5),
        'ssm_d': nrm(ks[25], (L, SSM_GROUPS, SSM_GROUP), 1.0),
        'ssm_glu_w': nrm(ks[26], (L, SSM_WIDTH, SSM_WIDTH), SSM_WIDTH ** -0.5),
        'ssm_glu_b': nrm(ks[27], (L, SSM_WIDTH), 0.02),
    }


def reference(x, ln_g, ln_b, ffn1_in, ffn1_out, ffn2_in, ffn2_out, w_in, w_out,
              pool_w, pool_scale, cmp_pe_k, cmp_pe_v, cmp_k_w1, cmp_k_w2, cmp_v_w1, cmp_v_w2,
              ssm_lam_re, ssm_lam_im, ssm_log_dt, ssm_b_re, ssm_b_im, ssm_c_re, ssm_c_im,
              ssm_d, ssm_glu_w, ssm_glu_b):
    cos, sin = rope_tables(x.shape[1])
    h = x
    for l in range(DEPTH):
        h = layer_norm(ALPHA * h + 0.5 * swiglu(h, ffn1_in[l], ffn1_out[l]), ln_g[l, 0], ln_b[l, 0])
        mix = hybrid_mixer(h, cos, sin, w_in[l], w_out[l], pool_w[l], pool_scale[l],
                           cmp_pe_k[l], cmp_pe_v[l], cmp_k_w1[l], cmp_k_w2[l], cmp_v_w1[l], cmp_v_w2[l],
                           ssm_lam_re[l], ssm_lam_im[l], ssm_log_dt[l], ssm_b_re[l], ssm_b_im[l],
                           ssm_c_re[l], ssm_c_im[l], ssm_d[l], ssm_glu_w[l], ssm_glu_b[l])
        h = layer_norm(ALPHA * h + mix, ln_g[l, 1], ln_b[l, 1])
        h = layer_norm(ALPHA * h + 0.5 * swiglu(h, ffn2_in[l], ffn2_out[l]), ln_g[l, 2], ln_b[l, 2])
    return h
```

```cpp
#include <hip/hip_runtime.h>
#include <hip/hip_cooperative_groups.h>
#include <stdint.h>
#include <type_traits>
#include <cstdio>
namespace cg = cooperative_groups;

#ifndef MULTI
#define MULTI 0
#endif

#define DEVI __device__ __forceinline__
#define TIDX tid_()
#define LAS __attribute__((address_space(3)))
typedef unsigned short bf16_t;
typedef short bf16x8 __attribute__((ext_vector_type(8)));
typedef short bf16x4 __attribute__((ext_vector_type(4)));
typedef float f32x4 __attribute__((ext_vector_type(4)));
typedef float f32x2v __attribute__((ext_vector_type(2)));
typedef unsigned u32x4 __attribute__((ext_vector_type(4)));
typedef unsigned u32x2 __attribute__((ext_vector_type(2)));

constexpr int T_ = 16384, S_ = 8192, D_ = 1024, DFF = 2816, NIN = 1920, NINSRC = 1816;
constexpr float ALPHA = 1.6817928305074290f;
constexpr float LOG2E = 1.4426950408889634f;
constexpr float NEGBIG = -1e30f;

constexpr size_t SZ_W1T = (size_t)5632 * 1024 * 2, SZ_W2T = (size_t)1024 * 2816 * 2, SZ_WINT = (size_t)NIN * 1024 * 2,
                 SZ_WOUTT = (size_t)1024 * 1024 * 2, SZ_CW1T = (size_t)128 * 2048 * 2, SZ_GLUT = (size_t)256 * 256 * 2;
constexpr size_t OL_W1T0 = 0, OL_W1T1 = OL_W1T0 + SZ_W1T, OL_W2T0 = OL_W1T1 + SZ_W1T, OL_W2T1 = OL_W2T0 + SZ_W2T,
                 OL_WINT = OL_W2T1 + SZ_W2T, OL_WOUTT = OL_WINT + SZ_WINT, OL_CW1K = OL_WOUTT + SZ_WOUTT, OL_CW1V = OL_CW1K + SZ_CW1T,
                 OL_GLUT = OL_CW1V + SZ_CW1T, SZ_LAYER = OL_GLUT + SZ_GLUT;
constexpr size_t OFF_W = 0;
constexpr size_t OFF_COS = OFF_W + 4 * SZ_LAYER, OFF_SIN = OFF_COS + (size_t)S_ * 32 * 4, OFF_CBIAS = OFF_SIN + (size_t)S_ * 32 * 4,
                 OFF_S5A = OFF_CBIAS + 32768, OFF_S5B = OFF_S5A + (size_t)4 * 16 * 64 * 16, OFF_H = OFF_S5B + (size_t)4 * 16 * 64 * 32 * 4,
                 OFF_HB = OFF_H + (size_t)T_ * D_ * 4, OFF_U = OFF_HB + (size_t)T_ * D_ * 2;
constexpr size_t OFF_ACT = OFF_U;
constexpr size_t OFF_Q = OFF_U, OFF_KCMP = OFF_Q + (size_t)T_ * 512 * 2, OFF_VCMP = OFF_KCMP + (size_t)T_ * 128 * 2,
                 OFF_KSLC = OFF_VCMP + (size_t)T_ * 128 * 2, OFF_VSLCT = OFF_KSLC + (size_t)T_ * 128 * 2, OFF_KWIN = OFF_VSLCT + (size_t)T_ * 128 * 2,
                 OFF_VWINT = OFF_KWIN + (size_t)T_ * 128 * 2, OFF_KC = OFF_VWINT + (size_t)T_ * 128 * 2, OFF_VCT = OFF_KC + (size_t)4 * 512 * 64 * 2,
                 OFF_GATES = OFF_VCT + (size_t)4 * 512 * 64 * 2, OFF_UPOOL = OFF_GATES + (size_t)T_ * 24 * 4, OFF_USSM = OFF_UPOOL + (size_t)T_ * 256 * 4,
                 OFF_E = OFF_USSM + (size_t)T_ * 256 * 4, OFF_YG = OFF_E + (size_t)2 * 128 * 16 * 64 * 8, OFF_HIDP = OFF_YG + (size_t)T_ * 256 * 2,
                 OFF_MIXEND = OFF_HIDP + (size_t)8 * 2048 * 128 * 4;
constexpr size_t OFF_ACTEND = OFF_ACT + (size_t)T_ * DFF * 2;
constexpr size_t WS_NEED = (OFF_MIXEND > OFF_ACTEND ? OFF_MIXEND : OFF_ACTEND);
constexpr size_t OFF_CAT = OFF_HB;
constexpr size_t OFF_BAR = WS_NEED, BAR_BYTES = 16384, OFF_STATS = OFF_BAR + BAR_BYTES, WS_TOTAL = OFF_STATS + (size_t)T_ * 8;

struct Params {
    const float *x, *ln_g, *ln_b, *ffn1_in, *ffn1_out, *ffn2_in, *ffn2_out, *w_in, *w_out, *pool_w, *pool_scale, *pe_k, *pe_v,
        *ck_w1, *ck_w2, *cv_w1, *cv_w2, *lam_re, *lam_im, *log_dt, *b_re, *b_im, *c_re, *c_im, *ssm_d, *glu_w, *glu_b;
    float* out;
    unsigned char* ws;
};

DEVI int tid_() { int t = threadIdx.x; asm volatile("" : "+v"(t)); return t; }
DEVI int wave_() { return __builtin_amdgcn_readfirstlane(tid_() >> 6); }
typedef __bf16 bf16x2n __attribute__((ext_vector_type(2)));
DEVI unsigned pk_bf16(float lo, float hi) { const bf16x2n r = __builtin_convertvector((f32x2v){lo, hi}, bf16x2n); return __builtin_bit_cast(unsigned, r); }
DEVI bf16_t f2bf(float f) { return (bf16_t)(pk_bf16(f, 0.f) & 0xffffu); }
DEVI float fast_exp2(float x) { return __builtin_amdgcn_exp2f(x); }
DEVI float rcp_(float x) { return __builtin_amdgcn_rcpf(x); }
DEVI float sigmoidf_(float x) { return rcp_(1.0f + fast_exp2(-x * LOG2E)); }
DEVI float gelu_tanh(float x) {
    const float z = 0.7978845608028654f * (x + 0.044715f * x * x * x);
    const float th = 1.0f - 2.0f * rcp_(1.0f + fast_exp2(z * (2.0f * LOG2E)));
    return 0.5f * x * (1.0f + th);
}
DEVI f32x4 mfma16(bf16x8 a, bf16x8 b, f32x4 c) { return __builtin_amdgcn_mfma_f32_16x16x32_bf16(a, b, c, 0, 0, 0); }

constexpr int LDS_ROW = 72;
constexpr int TILE_ELEMS = 128 * LDS_ROW;
constexpr int SMEM_BYTES = 4 * TILE_ELEMS * 2;

DEVI void glds16(const void* gsrc, unsigned lds_dst) {
    unsigned keep;
    asm volatile("s_mov_b32 %0, m0\n\ts_mov_b32 m0, %2\n\ts_nop 0\n\tglobal_load_lds_dwordx4 %1, off\n\ts_mov_b32 m0, %0"
                 : "=&s"(keep) : "v"(gsrc), "s"(lds_dst) : "memory");
}
DEVI void glds_tile8(const unsigned (&va)[4], const unsigned (&vb)[4], const void* sa, const void* sb, unsigned lds) {
    unsigned keep;
    asm volatile(
        "s_mov_b32 %[keep], m0\n\t"
        "s_mov_b32 m0, %[l]\n\ts_nop 0\n\tglobal_load_lds_dwordx4 %[a0], %[sa]\n\t"
        "s_add_u32 m0, m0, 0x1000\n\ts_nop 0\n\tglobal_load_lds_dwordx4 %[a1], %[sa]\n\t"
        "s_add_u32 m0, m0, 0x1000\n\ts_nop 0\n\tglobal_load_lds_dwordx4 %[a2], %[sa]\n\t"
        "s_add_u32 m0, m0, 0x1000\n\ts_nop 0\n\tglobal_load_lds_dwordx4 %[a3], %[sa]\n\t"
        "s_add_u32 m0, m0, 0x1000\n\ts_nop 0\n\tglobal_load_lds_dwordx4 %[b0], %[sb]\n\t"
        "s_add_u32 m0, m0, 0x1000\n\ts_nop 0\n\tglobal_load_lds_dwordx4 %[b1], %[sb]\n\t"
        "s_add_u32 m0, m0, 0x1000\n\ts_nop 0\n\tglobal_load_lds_dwordx4 %[b2], %[sb]\n\t"
        "s_add_u32 m0, m0, 0x1000\n\ts_nop 0\n\tglobal_load_lds_dwordx4 %[b3], %[sb]\n\t"
        "s_mov_b32 m0, %[keep]"
        : [keep] "=&s"(keep)
        : [a0] "v"(va[0]), [a1] "v"(va[1]), [a2] "v"(va[2]), [a3] "v"(va[3]), [b0] "v"(vb[0]), [b1] "v"(vb[1]), [b2] "v"(vb[2]), [b3] "v"(vb[3]),
          [sa] "s"(sa), [sb] "s"(sb), [l] "s"(lds)
        : "memory", "scc");
}
DEVI void glds_tile4(unsigned v0, unsigned v1, const void* sk, const void* sv, unsigned lds) {
    unsigned keep;
    asm volatile(
        "s_mov_b32 %[keep], m0\n\t"
        "s_mov_b32 m0, %[l]\n\ts_nop 0\n\tglobal_load_lds_dwordx4 %[a0], %[sk]\n\t"
        "s_add_u32 m0, m0, 0x1000\n\ts_nop 0\n\tglobal_load_lds_dwordx4 %[a1], %[sk]\n\t"
        "s_add_u32 m0, m0, 0x1000\n\ts_nop 0\n\tglobal_load_lds_dwordx4 %[a0], %[sv]\n\t"
        "s_add_u32 m0, m0, 0x1000\n\ts_nop 0\n\tglobal_load_lds_dwordx4 %[a1], %[sv]\n\t"
        "s_mov_b32 m0, %[keep]"
        : [keep] "=&s"(keep)
        : [a0] "v"(v0), [a1] "v"(v1), [sk] "s"(sk), [sv] "s"(sv), [l] "s"(lds)
        : "memory", "scc");
}
template <bool SWAP, typename RowPtr>
DEVI void gemm_tile(f32x4 (&acc)[4][4], RowPtr rowptr, int kstepA, const bf16_t* __restrict__ Btile, int K, bf16_t* smem, int ldb = 0, bool first_issued = false) {
    if (ldb == 0) ldb = K;
    const int tid = TIDX, lane = tid & 63, wave = wave_(), wr = wave >> 1, wc = wave & 1, l16 = lane & 15, quad = lane >> 4;
#pragma unroll
    for (int i = 0; i < 4; ++i)
#pragma unroll
        for (int j = 0; j < 4; ++j) acc[i][j] = (f32x4){0.f, 0.f, 0.f, 0.f};
    const bf16_t* a0p = rowptr(0);
    unsigned va[4], vb[4];
#pragma unroll
    for (int j = 0; j < 4; ++j) {
        const int R = j * 32 + (tid >> 3), c = (tid & 7) ^ ((R >> 1) & 7);
        va[j] = (unsigned)((const unsigned char*)(rowptr(R) + c * 8) - (const unsigned char*)a0p);
        vb[j] = (unsigned)(((size_t)R * ldb + c * 8) * 2);
    }
    unsigned char* sbase = (unsigned char*)smem;
    const int nk = K >> 6;
    const unsigned lds0 = (unsigned)(size_t)((LAS unsigned char*)sbase) + (unsigned)wave * 1024u;
    auto issue = [&](int kt, int st) {
        glds_tile8(va, vb, a0p + (size_t)kt * kstepA, Btile + (size_t)kt * 64, __builtin_amdgcn_readfirstlane(lds0 + st * 32768));
    };
    const int sw0 = (quad ^ (l16 >> 1)) * 16;
    const int aoffb = (wr * 64 + l16) * 128, boffb = 16384 + (wc * 64 + l16) * 128;
    if (!first_issued) issue(0, 0);
#pragma unroll 1
    for (int kt = 0; kt < nk; ++kt) {
        asm volatile("s_waitcnt vmcnt(0)\n\ts_barrier" ::: "memory");
        if (kt + 1 < nk) issue(kt + 1, (kt + 1) & 1);
        const unsigned char* cs = sbase + (kt & 1) * 32768;
        bf16x8 af0[4], bf0[4], af1[4], bf1[4];
#pragma unroll
        for (int i = 0; i < 4; ++i) { af0[i] = *(const bf16x8*)(cs + aoffb + i * 2048 + sw0); bf0[i] = *(const bf16x8*)(cs + boffb + i * 2048 + sw0); }
#pragma unroll
        for (int i = 0; i < 4; ++i) { af1[i] = *(const bf16x8*)(cs + aoffb + i * 2048 + (sw0 ^ 64)); bf1[i] = *(const bf16x8*)(cs + boffb + i * 2048 + (sw0 ^ 64)); }
        __builtin_amdgcn_sched_barrier(0);
#pragma unroll
        for (int i = 0; i < 4; ++i)
#pragma unroll
            for (int j = 0; j < 4; ++j) acc[i][j] = SWAP ? mfma16(bf0[j], af0[i], acc[i][j]) : mfma16(af0[i], bf0[j], acc[i][j]);
        __builtin_amdgcn_sched_barrier(0);
#pragma unroll
        for (int i = 0; i < 4; ++i)
#pragma unroll
            for (int j = 0; j < 4; ++j) acc[i][j] = SWAP ? mfma16(bf1[j], af1[i], acc[i][j]) : mfma16(af1[i], bf1[j], acc[i][j]);
    }
    __syncthreads();
}

DEVI void gemm_issue0(const bf16_t* Ab, int lda, const bf16_t* Btile, int ldb, bf16_t* smem) {
    const int tid = TIDX, wave = wave_();
    const unsigned lds0 = (unsigned)(size_t)((LAS unsigned char*)smem) + (unsigned)wave * 1024u;
    unsigned va[4], vb[4];
#pragma unroll
    for (int j = 0; j < 4; ++j) {
        const int R = j * 32 + (tid >> 3), c = (tid & 7) ^ ((R >> 1) & 7);
        va[j] = (unsigned)(((size_t)R * lda + c * 8) * 2);
        vb[j] = (unsigned)(((size_t)R * ldb + c * 8) * 2);
    }
    glds_tile8(va, vb, Ab, Btile, __builtin_amdgcn_readfirstlane(lds0));
}

DEVI bool tile_map(int it, int NTN, int& tm, int& tn) {
    const int G = gridDim.x;
    if ((G & 7) != 0) { const int t = blockIdx.x + it * G; if (t >= 128 * NTN) return false; tm = t / NTN; tn = t % NTN; return true; }
    const int x = blockIdx.x & 7, nb = G >> 3, q = it * nb + (blockIdx.x >> 3);
    if (q >= 16 * NTN) return false;
    const int full = NTN >> 3;
    int chunk, qq, w;
    if (q < full * 128) { chunk = q >> 7; qq = q & 127; w = 8; } else { chunk = full; qq = q - full * 128; w = NTN & 7; }
    tm = x * 16 + qq / w; tn = chunk * 8 + qq % w;
    return true;
}

DEVI int win_src_col(int n) { return n < 1536 ? n : (n < 1792 ? 1560 + (n - 1536) : (n < 1816 ? 1536 + (n - 1792) : -1)); }
DEVI int swiglu_src_col(int n) { const int t16 = n >> 4, pair = t16 >> 1, up = t16 & 1; return up * DFF + pair * 16 + (n & 15); }

DEVI void transpose_tile(const float* __restrict__ W, int Nsrc, bf16_t* __restrict__ out, int K, int perm, int tk, int tn, float* tl) {
    const int tid = TIDX;
    {
        const int n4 = (tid & 15) * 4, kr = tid >> 4;
        const int n = tn * 64 + n4;
        const int sc = perm == 1 ? swiglu_src_col(n) : (perm == 2 ? win_src_col(n) : n);
        f32x4 v[4];
#pragma unroll
        for (int i = 0; i < 4; ++i)
            v[i] = sc >= 0 ? *(const f32x4*)(W + (size_t)(tk * 64 + kr + 16 * i) * Nsrc + sc) : (f32x4){0.f, 0.f, 0.f, 0.f};
#pragma unroll
        for (int i = 0; i < 4; ++i)
#pragma unroll
            for (int e = 0; e < 4; ++e) tl[(kr + 16 * i) * 65 + n4 + e] = v[i][e];
    }
    __syncthreads();
    {
        const int k8 = (tid & 7) * 8, nr = tid >> 3;
#pragma unroll
        for (int i = 0; i < 2; ++i) {
            const int nn = nr + 32 * i;
            u32x4 pk;
            pk.x = pk_bf16(tl[(k8 + 0) * 65 + nn], tl[(k8 + 1) * 65 + nn]); pk.y = pk_bf16(tl[(k8 + 2) * 65 + nn], tl[(k8 + 3) * 65 + nn]);
            pk.z = pk_bf16(tl[(k8 + 4) * 65 + nn], tl[(k8 + 5) * 65 + nn]); pk.w = pk_bf16(tl[(k8 + 6) * 65 + nn], tl[(k8 + 7) * 65 + nn]);
            *(u32x4*)(out + (size_t)(tn * 64 + nn) * K + tk * 64 + k8) = pk;
        }
    }
    __syncthreads();
}

DEVI void dsincos(double x, double& s, double& c) {
    const double TWO_PI = 6.283185307179586476925;
    const double k = rint(x / TWO_PI);
    double r = fma(-k, TWO_PI, x);
    r = fma(-k, 2.4492935982947064e-16, r);
    const double y = r * 0.125, y2 = y * y;
    double sn = 1.0, cs = 1.0;
    sn = y * (1.0 + y2 * (-1.0 / 6 + y2 * (1.0 / 120 + y2 * (-1.0 / 5040 + y2 * (1.0 / 362880 + y2 * (-1.0 / 39916800 + y2 * (1.0 / 6227020800.0)))))));
    cs = 1.0 + y2 * (-0.5 + y2 * (1.0 / 24 + y2 * (-1.0 / 720 + y2 * (1.0 / 40320 + y2 * (-1.0 / 3628800 + y2 * (1.0 / 479001600.0 + y2 * (-1.0 / 87178291200.0)))))));
#pragma unroll
    for (int i = 0; i < 3; ++i) { const double s2 = 2.0 * sn * cs, c2 = cs * cs - sn * sn; sn = s2; cs = c2; }
    s = sn; c = cs;
}

DEVI void phase_prologue(const Params& p, unsigned char* smem_raw) {
    unsigned char* ws = p.ws;
    float* tl = (float*)smem_raw;
    constexpr int NTL = 5104, NT_W = 4 * NTL, NHB = 2048, NCS = 256, NCB = 64, NS5 = 64;
    constexpr int NSMALL = NCS + NCB + NS5;
    constexpr int TOTAL = NT_W + NHB + NCS + NCB + NS5;
    const int tid = TIDX;
    for (int item0 = blockIdx.x; item0 < TOTAL; item0 += gridDim.x) {
        const int item = item0 < NSMALL ? item0 + NT_W + NHB : item0 - NSMALL;
        if (item < NT_W) {
            const int l = item / NTL;
            int r = item % NTL;
            const float* W; bf16_t* out; int K, Nsrc, ntn, perm = 0;
            unsigned char* lw = ws + OFF_W + (size_t)l * SZ_LAYER;
            if (r < 1408) { W = p.ffn1_in + (size_t)l * 1024 * 5632; out = (bf16_t*)(lw + OL_W1T0); K = 1024; Nsrc = 5632; ntn = 88; perm = 1; }
            else if (r < 2816) { r -= 1408; W = p.ffn2_in + (size_t)l * 1024 * 5632; out = (bf16_t*)(lw + OL_W1T1); K = 1024; Nsrc = 5632; ntn = 88; perm = 1; }
            else if (r < 3520) { r -= 2816; W = p.ffn1_out + (size_t)l * 2816 * 1024; out = (bf16_t*)(lw + OL_W2T0); K = 2816; Nsrc = 1024; ntn = 16; }
            else if (r < 4224) { r -= 3520; W = p.ffn2_out + (size_t)l * 2816 * 1024; out = (bf16_t*)(lw + OL_W2T1); K = 2816; Nsrc = 1024; ntn = 16; }
            else if (r < 4704) { r -= 4224; W = p.w_in + (size_t)l * 1024 * NINSRC; out = (bf16_t*)(lw + OL_WINT); K = 1024; Nsrc = NINSRC; ntn = 30; perm = 2; }
            else if (r < 4960) { r -= 4704; W = p.w_out + (size_t)l * 1024 * 1024; out = (bf16_t*)(lw + OL_WOUTT); K = 1024; Nsrc = 1024; ntn = 16; }
            else if (r < 5024) { r -= 4960; W = p.ck_w1 + (size_t)l * 2048 * 128; out = (bf16_t*)(lw + OL_CW1K); K = 2048; Nsrc = 128; ntn = 2; }
            else if (r < 5088) { r -= 5024; W = p.cv_w1 + (size_t)l * 2048 * 128; out = (bf16_t*)(lw + OL_CW1V); K = 2048; Nsrc = 128; ntn = 2; }
            else { r -= 5088; W = p.glu_w + (size_t)l * 256 * 256; out = (bf16_t*)(lw + OL_GLUT); K = 256; Nsrc = 256; ntn = 4; }
            transpose_tile(W, Nsrc, out, K, perm, r / ntn, r % ntn, tl);
        } else if (item < NT_W + NHB) {
            const int it = item - NT_W;
            const float* src = p.x + (size_t)it * 8192;
            bf16_t* dst = (bf16_t*)(ws + OFF_HB) + (size_t)it * 8192;
#pragma unroll
            for (int i = 0; i < 4; ++i) {
                const int e = (i * 256 + tid) * 8;
                const float4 a = *(const float4*)(src + e), b = *(const float4*)(src + e + 4);
                uint4 o; o.x = pk_bf16(a.x, a.y); o.y = pk_bf16(a.z, a.w); o.z = pk_bf16(b.x, b.y); o.w = pk_bf16(b.z, b.w);
                *(uint4*)(dst + e) = o;
            }
        } else if (item < NT_W + NHB + NCS) {
            const int it = item - NT_W - NHB;
            float* ct = (float*)(ws + OFF_COS); float* st = (float*)(ws + OFF_SIN);
#pragma unroll
            for (int i = 0; i < 4; ++i) {
                const int e = it * 1024 + i * 256 + tid;
                const int s = e >> 5, d = e & 31;
                const float inv = 1.0f / powf(10000.0f, (float)(2 * d) / 64.0f);
                const float ang = (float)s * inv;
                double sn, cs; dsincos((double)ang, sn, cs);
                ct[e] = (float)cs; st[e] = (float)sn;
            }
        } else if (item < NT_W + NHB + NCS + NCB) {
            const int it = item - NT_W - NHB - NCS;
            const int job = it >> 3, sl = it & 7, l = job >> 1, kv = job & 1;
            const float* pe = (kv ? p.pe_v : p.pe_k) + (size_t)l * 2048;
            const float* w1 = (kv ? p.cv_w1 : p.ck_w1) + (size_t)l * 2048 * 128;
            const int n = tid & 127, half = tid >> 7;
            float s = 0.f;
            const int k0 = sl * 256 + half * 128;
#pragma unroll 16
            for (int k = k0; k < k0 + 128; ++k) s += pe[k] * w1[(size_t)k * 128 + n];
            __syncthreads();
            if (half) tl[n] = s;
            __syncthreads();
            if (!half) ((float*)(ws + OFF_CBIAS))[it * 128 + n] = s + tl[n];
            __syncthreads();
        } else {
            const int it = item - NT_W - NHB - NCS - NCB;
            if (tid < 64) {
                const int sidx = it * 64 + tid;
                const double dt = exp((double)p.log_dt[it]);
                const double lr = p.lam_re[sidx], li = p.lam_im[sidx];
                const double mag = exp(lr * dt);
                double sn, cs; dsincos(li * dt, sn, cs);
                const double ar = mag * cs, ai = mag * sn;
                const double den = lr * lr + li * li;
                const double fr = ((ar - 1.0) * lr + ai * li) / den, fi = (ai * lr - (ar - 1.0) * li) / den;
                const double magL = exp(lr * dt * 64.0);
                double snL, csL; dsincos(li * dt * 64.0, snL, csL);
                float4 a4; a4.x = (float)ar; a4.y = (float)ai; a4.z = (float)(magL * csL); a4.w = (float)(magL * snL);
                ((float4*)(ws + OFF_S5A))[sidx] = a4;
                float* bb = (float*)(ws + OFF_S5B) + (size_t)sidx * 32;
                for (int c = 0; c < 16; ++c) {
                    const double br = p.b_re[(size_t)sidx * 16 + c], bi = p.b_im[(size_t)sidx * 16 + c];
                    bb[c] = (float)(fr * br - fi * bi);
                    bb[16 + c] = (float)(fr * bi + fi * br);
                }
            }
        }
    }
}

DEVI void phase_ffn_in(const Params& p, int l, int which, bf16_t* smem) {
    unsigned char* ws = p.ws;
    const bf16_t* A = (const bf16_t*)(ws + OFF_HB);
    const bf16_t* Bt = (const bf16_t*)(ws + OFF_W + (size_t)l * SZ_LAYER + (which ? OL_W1T1 : OL_W1T0));
    bf16_t* act = (bf16_t*)(ws + OFF_ACT);
    const int lane = TIDX & 63, wave = wave_(), wr = wave >> 1, wc = wave & 1, l16 = lane & 15, quad = lane >> 4;
    int tm, tn;
    bool have = tile_map(0, 44, tm, tn);
    if (have) gemm_issue0(A + (size_t)tm * 128 * 1024, 1024, Bt + (size_t)tn * 128 * 1024, 1024, smem);
    for (int it = 0; have; ++it) {
        f32x4 acc[4][4];
        const bf16_t* Ab = A + (size_t)tm * 128 * 1024;
        gemm_tile<true>(acc, [&](int r) { return Ab + (size_t)r * 1024; }, 64, Bt + (size_t)tn * 128 * 1024, 1024, smem, 0, true);
        int tm2 = 0, tn2 = 0;
        const bool have2 = tile_map(it + 1, 44, tm2, tn2);
        if (have2) gemm_issue0(A + (size_t)tm2 * 128 * 1024, 1024, Bt + (size_t)tn2 * 128 * 1024, 1024, smem);
        const int colb = (tn * 128 + wc * 64) >> 1;
#pragma unroll
        for (int mi = 0; mi < 4; ++mi)
#pragma unroll
            for (int pp = 0; pp < 2; ++pp) {
                float v[4];
#pragma unroll
                for (int r = 0; r < 4; ++r) { const float g = acc[mi][2 * pp][r], u = acc[mi][2 * pp + 1][r]; v[r] = g * u * rcp_(1.0f + fast_exp2(-g * LOG2E)); }
                const int row = tm * 128 + wr * 64 + mi * 16 + l16;
                u32x2 pk; pk.x = pk_bf16(v[0], v[1]); pk.y = pk_bf16(v[2], v[3]);
                *(u32x2*)(act + (size_t)row * DFF + colb + pp * 16 + quad * 4) = pk;
            }
        tm = tm2; tn = tn2; have = have2;
    }
}

DEVI void phase_gemm_res(const Params& p, const bf16_t* A, int K, const bf16_t* Bt, const float* xraw, int lnidx, float bscale, bf16_t* smem) {
    float* hbuf = (float*)(p.ws + OFF_H);
    const f32x2v* stats = (const f32x2v*)(p.ws + OFF_STATS);
    const float* lg = p.ln_g + (size_t)lnidx * D_;
    const float* lb = p.ln_b + (size_t)lnidx * D_;
    const int lane = TIDX & 63, wave = wave_(), wr = wave >> 1, wc = wave & 1, l16 = lane & 15, quad = lane >> 4;
    int tm, tn;
    bool have = tile_map(0, 8, tm, tn);
    if (have) gemm_issue0(A + (size_t)tm * 128 * K, K, Bt + (size_t)tn * 128 * K, K, smem);
    for (int it = 0; have; ++it) {
        f32x4 acc[4][4];
        const bf16_t* Ab = A + (size_t)tm * 128 * K;
        gemm_tile<true>(acc, [&](int r) { return Ab + (size_t)r * K; }, 64, Bt + (size_t)tn * 128 * K, K, smem, 0, true);
        int tm2 = 0, tn2 = 0;
        const bool have2 = tile_map(it + 1, 8, tm2, tn2);
        if (have2) gemm_issue0(A + (size_t)tm2 * 128 * K, K, Bt + (size_t)tn2 * 128 * K, K, smem);
        if (xraw) {
#pragma unroll
            for (int mi = 0; mi < 4; ++mi)
#pragma unroll
                for (int ni = 0; ni < 4; ++ni) {
                    const size_t idx = (size_t)(tm * 128 + wr * 64 + mi * 16 + l16) * D_ + tn * 128 + wc * 64 + ni * 16 + quad * 4;
                    const f32x4 rv = *(const f32x4*)(xraw + idx);
                    *(f32x4*)(hbuf + idx) = rv * ALPHA + acc[mi][ni] * bscale;
                }
        } else {
            f32x4 g4[4], b4[4];
#pragma unroll
            for (int ni = 0; ni < 4; ++ni) {
                const int col = tn * 128 + wc * 64 + ni * 16 + quad * 4;
                g4[ni] = *(const f32x4*)(lg + col) * ALPHA; b4[ni] = *(const f32x4*)(lb + col) * ALPHA;
            }
#pragma unroll
            for (int mi = 0; mi < 4; ++mi) {
                const int row = tm * 128 + wr * 64 + mi * 16 + l16;
                const f32x2v st = stats[row];
#pragma unroll
                for (int ni = 0; ni < 4; ++ni) {
                    const size_t idx = (size_t)row * D_ + tn * 128 + wc * 64 + ni * 16 + quad * 4;
                    const f32x4 rv = *(const f32x4*)(hbuf + idx);
                    *(f32x4*)(hbuf + idx) = ((rv - st[0]) * st[1]) * g4[ni] + b4[ni] + acc[mi][ni] * bscale;
                }
            }
        }
        tm = tm2; tn = tn2; have = have2;
    }
}

DEVI void phase_ln(const Params& p, int l, int which, bool last) {
    float* hbuf = (float*)(p.ws + OFF_H);
    bf16_t* hb = (bf16_t*)(p.ws + OFF_HB);
    float* dst = last ? p.out : hbuf;
    const float* g = p.ln_g + (size_t)(l * 3 + which) * D_;
    const float* b = p.ln_b + (size_t)(l * 3 + which) * D_;
    const int lane = TIDX & 63, wave = wave_();
    const int stride = gridDim.x * 4;
    int row = blockIdx.x * 4 + wave;
    f32x4 nx[4];
    if (row < T_) {
#pragma unroll
        for (int i = 0; i < 4; ++i) nx[i] = *(const f32x4*)(hbuf + (size_t)row * D_ + i * 256 + lane * 4);
    }
    for (; row < T_; row += stride) {
        f32x4 v[4];
#pragma unroll
        for (int i = 0; i < 4; ++i) v[i] = nx[i];
        const int rn = row + stride < T_ ? row + stride : row;
#pragma unroll
        for (int i = 0; i < 4; ++i) nx[i] = *(const f32x4*)(hbuf + (size_t)rn * D_ + i * 256 + lane * 4);
        float s = 0.f;
#pragma unroll
        for (int i = 0; i < 4; ++i) s += (v[i][0] + v[i][1]) + (v[i][2] + v[i][3]);
#pragma unroll
        for (int o = 32; o > 0; o >>= 1) s += __shfl_xor(s, o);
        const float mu = s * (1.0f / 1024.0f);
        float q = 0.f;
#pragma unroll
        for (int i = 0; i < 4; ++i) { const f32x4 d = v[i] - mu; q += (d[0] * d[0] + d[1] * d[1]) + (d[2] * d[2] + d[3] * d[3]); }
#pragma unroll
        for (int o = 32; o > 0; o >>= 1) q += __shfl_xor(q, o);
        const float rstd = rsqrtf(q * (1.0f / 1024.0f) + 1e-5f);
#pragma unroll
        for (int i = 0; i < 4; ++i) {
            const int c0 = i * 256 + lane * 4;
            const f32x4 gg = *(const f32x4*)(g + c0), bb = *(const f32x4*)(b + c0);
            const f32x4 o = (v[i] - mu) * rstd * gg + bb;
            if (last) *(f32x4*)(dst + (size_t)row * D_ + c0) = o;
            else { u32x2 pk; pk.x = pk_bf16(o[0], o[1]); pk.y = pk_bf16(o[2], o[3]); *(u32x2*)(hb + (size_t)row * D_ + c0) = pk; }
        }
        if (!last && lane == 0) ((f32x2v*)(p.ws + OFF_STATS))[row] = (f32x2v){mu, rstd};
    }
}

DEVI void phase_inproj(const Params& p, int l, bf16_t* smem) {
    unsigned char* ws = p.ws;
    const bf16_t* A = (const bf16_t*)(ws + OFF_HB);
    const bf16_t* Bt = (const bf16_t*)(ws + OFF_W + (size_t)l * SZ_LAYER + OL_WINT);
    const float* cosT = (const float*)(ws + OFF_COS);
    const float* sinT = (const float*)(ws + OFF_SIN);
    bf16_t* qo = (bf16_t*)(ws + OFF_Q);
    float* upool = (float*)(ws + OFF_UPOOL);
    float* ussm = (float*)(ws + OFF_USSM);
    float* gates = (float*)(ws + OFF_GATES);
    const int lane = TIDX & 63, wave = wave_(), wr = wave >> 1, wc = wave & 1, l16 = lane & 15, quad = lane >> 4;
    for (int it = 0;; ++it) {
        int tm, tn; if (!tile_map(it, 15, tm, tn)) break;
        f32x4 acc[4][4];
        const bf16_t* Ab = A + (size_t)tm * 128 * 1024;
        const int cb = tn * 128 + wc * 64;
        const int row0 = tm * 128 + wr * 64;
        if (tn == 9 || tn == 11) {
            gemm_tile<false>(acc, [&](int r) { return Ab + (size_t)r * 1024; }, 64, Bt + (size_t)tn * 128 * 1024, 1024, smem);
            const int g = ((cb - 768) >> 6) & 1;
            bf16_t* dst = (bf16_t*)(ws + (tn == 9 ? OFF_VSLCT : OFF_VWINT));
#pragma unroll
            for (int mi = 0; mi < 4; ++mi) {
                const int tok = row0 + mi * 16 + quad * 4, s = tok & (S_ - 1), b = tok >> 13;
                bf16_t* bp = dst + ((size_t)(b * 2 + g) * 128 + (s >> 6)) * 4096 + (((s >> 2) & 3) * 16 + ((s >> 4) & 3) * 4);
#pragma unroll
                for (int ni = 0; ni < 4; ++ni) {
                    u32x2 pk; pk.x = pk_bf16(acc[mi][ni][0], acc[mi][ni][1]); pk.y = pk_bf16(acc[mi][ni][2], acc[mi][ni][3]);
                    *(u32x2*)(bp + (ni * 16 + l16) * 64) = pk;
                }
            }
            continue;
        }
        gemm_tile<true>(acc, [&](int r) { return Ab + (size_t)r * 1024; }, 64, Bt + (size_t)tn * 128 * 1024, 1024, smem);
        if (cb < 256 || (cb >= 1536 && cb < 1792)) {
            float* dst = cb < 256 ? (upool + cb) : (ussm + (cb - 1536));
#pragma unroll
            for (int mi = 0; mi < 4; ++mi)
#pragma unroll
                for (int ni = 0; ni < 4; ++ni) *(f32x4*)(dst + (size_t)(row0 + mi * 16 + l16) * 256 + ni * 16 + quad * 4) = acc[mi][ni];
        } else if (cb < 1536) {
            const bool isq = cb < 768;
            const int kvi = isq ? -1 : (cb - 768) >> 7, g = isq ? 0 : ((cb - 768) >> 6) & 1;
#pragma unroll
            for (int mi = 0; mi < 4; ++mi) {
                const int tok = row0 + mi * 16 + l16, s = tok & (S_ - 1), b = tok >> 13;
                bf16_t* base;
                if (isq) base = qo + (size_t)tok * 512 + ((cb - 256) >> 6) * 64;
                else if (kvi == 0) base = (bf16_t*)(ws + OFF_KCMP) + (size_t)tok * 128 + g * 64;
                else if (kvi == 1) base = (bf16_t*)(ws + OFF_VCMP) + (size_t)tok * 128 + g * 64;
                else base = (bf16_t*)(ws + (kvi == 2 ? OFF_KSLC : OFF_KWIN)) + ((size_t)(b * 2 + g) * S_ + s) * 64;
                if (kvi == 1) {
#pragma unroll
                    for (int ni = 0; ni < 4; ++ni) {
                        u32x2 pk; pk.x = pk_bf16(acc[mi][ni][0], acc[mi][ni][1]); pk.y = pk_bf16(acc[mi][ni][2], acc[mi][ni][3]);
                        *(u32x2*)(base + ni * 16 + quad * 4) = pk;
                    }
                } else {
                    const float sc = isq ? 0.125f : 1.0f;
#pragma unroll
                    for (int ni = 0; ni < 2; ++ni) {
                        const int d0 = ni * 16 + quad * 4;
                        const f32x4 c4 = *(const f32x4*)(cosT + s * 32 + d0), s4 = *(const f32x4*)(sinT + s * 32 + d0);
                        const f32x4 x1 = acc[mi][ni], x2 = acc[mi][ni + 2];
                        const f32x4 o1 = (x1 * c4 - x2 * s4) * sc, o2 = (x2 * c4 + x1 * s4) * sc;
                        u32x2 p1, p2;
                        p1.x = pk_bf16(o1[0], o1[1]); p1.y = pk_bf16(o1[2], o1[3]);
                        p2.x = pk_bf16(o2[0], o2[1]); p2.y = pk_bf16(o2[2], o2[3]);
                        *(u32x2*)(base + d0) = p1;
                        *(u32x2*)(base + d0 + 32) = p2;
                    }
                }
            }
        } else if (cb == 1792) {
#pragma unroll
            for (int mi = 0; mi < 4; ++mi)
#pragma unroll
                for (int ni = 0; ni < 2; ++ni) {
                    const int c0 = ni * 16 + quad * 4;
                    if (c0 < 24) {
                        f32x4 gv;
#pragma unroll
                        for (int r = 0; r < 4; ++r) gv[r] = sigmoidf_(acc[mi][ni][r]);
                        *(f32x4*)(gates + (size_t)(row0 + mi * 16 + l16) * 24 + c0) = gv;
                    }
                }
        }
    }
}

DEVI void compress_partial(const Params& p, int l, int kv, int tmc, int ks, bf16_t* smem) {
    unsigned char* ws = p.ws;
    const bf16_t* src = (const bf16_t*)(ws + (kv ? OFF_VCMP : OFF_KCMP));
    const bf16_t* Bt = (const bf16_t*)(ws + OFF_W + (size_t)l * SZ_LAYER + (kv ? OL_CW1V : OL_CW1K)) + ks * 512;
    float* hp = (float*)(ws + OFF_HIDP) + ((size_t)(ks * 2 + kv) * 2048 + tmc * 128) * 128;
    const int tid = TIDX, lane = tid & 63, wave = wave_(), wr = wave >> 1, wc = wave & 1, l16 = lane & 15, quad = lane >> 4;
    f32x4 acc[4][4];
    gemm_tile<true>(acc, [&](int r) {
        const int row = tmc * 128 + r, bg = row >> 9, c = row & 511;
        return src + ((size_t)((bg >> 1) * S_ + c * 16 + ks * 8)) * 128 + (bg & 1) * 64; }, 128, Bt, 512, smem, 2048);
#pragma unroll
    for (int mi = 0; mi < 4; ++mi)
#pragma unroll
        for (int ni = 0; ni < 4; ++ni) *(f32x4*)(hp + (size_t)(wr * 64 + mi * 16 + l16) * 128 + wc * 64 + ni * 16 + quad * 4) = acc[mi][ni];
}

DEVI void compress_finish(const Params& p, int l, int kv, int t32, float* sm) {
    unsigned char* ws = p.ws;
    const float* bias = (const float*)(ws + OFF_CBIAS) + (l * 2 + kv) * 8 * 128;
    const float* w2 = (kv ? p.cv_w2 : p.ck_w2) + (size_t)l * 128 * 64;
    const float* hp = (const float*)(ws + OFF_HIDP) + ((size_t)kv * 2048 + t32 * 32) * 128;
    float* hid = sm;
    float* w2s = sm + 32 * 129 + 3;
    w2s = sm + 4160;
    const int tid = TIDX;
#pragma unroll
    for (int i = 0; i < 8; ++i) *(f32x4*)(w2s + (i * 256 + tid) * 4) = *(const f32x4*)(w2 + (i * 256 + tid) * 4);
#pragma unroll
    for (int i = 0; i < 4; ++i) {
        const int e = (i * 256 + tid) * 4, row = e >> 7, col = e & 127;
        f32x4 v = *(const f32x4*)(bias + col);
#pragma unroll
        for (int sl = 1; sl < 8; ++sl) v += *(const f32x4*)(bias + sl * 128 + col);
#pragma unroll
        for (int ks = 0; ks < 4; ++ks) v += *(const f32x4*)(hp + (size_t)ks * 2 * 2048 * 128 + (size_t)row * 128 + col);
#pragma unroll
        for (int r = 0; r < 4; ++r) hid[row * 129 + col + r] = gelu_tanh(v[r]);
    }
    __syncthreads();
    {
        const int d = tid & 63, rq = tid >> 6;
        float o[8];
#pragma unroll
        for (int i = 0; i < 8; ++i) o[i] = 0.f;
#pragma unroll 4
        for (int n = 0; n < 128; ++n) {
            const float w = w2s[n * 64 + d];
#pragma unroll
            for (int i = 0; i < 8; ++i) o[i] += hid[(rq * 8 + i) * 129 + n] * w;
        }
        if (!kv) {
            bf16_t* kc = (bf16_t*)(ws + OFF_KC);
#pragma unroll
            for (int i = 0; i < 8; ++i) kc[(size_t)(t32 * 32 + rq * 8 + i) * 64 + d] = f2bf(o[i]);
        } else {
            bf16_t* vct = (bf16_t*)(ws + OFF_VCT);
#pragma unroll
            for (int i = 0; i < 8; ++i) {
                const int row = t32 * 32 + rq * 8 + i, bg = row >> 9, c = row & 511;
                vct[((size_t)(bg * 8 + (c >> 6)) * 64 + d) * 64 + (((c >> 2) & 3) * 16 + ((c >> 4) & 3) * 4 + (c & 3))] = f2bf(o[i]);
            }
        }
    }
    __syncthreads();
}

DEVI void phase_m2b(const Params& p, int l, unsigned char* smem) {
    for (int item = blockIdx.x; item < 128; item += gridDim.x) compress_finish(p, l, item >> 6, item & 63, (float*)smem);
}

DEVI void pool_item(const Params& p, int l, int tp, int gi, float* sm) {
    unsigned char* ws = p.ws;
    const float* upool = (const float*)(ws + OFF_UPOOL);
    bf16_t* cat = (bf16_t*)(ws + OFF_CAT);
    float* ul = sm;
    bf16_t* pb = (bf16_t*)(sm + 80 * 64);
    bf16_t* wt = pb + 64 * 72;
    const int tid = TIDX, lane = tid & 63, wave = wave_(), l16 = lane & 15, quad = lane >> 4;
    const int tok0 = tp * 64, s0 = tok0 & (S_ - 1);
    const int w = 2 << gi;
#pragma unroll
    for (int i = 0; i < 5; ++i) {
        const int idx = i * 256 + tid, row = idx >> 4, c4 = (idx & 15) * 4;
        const int sidx = s0 - 16 + row;
        const f32x4 v = sidx >= 0 ? *(const f32x4*)(upool + (size_t)(tok0 - 16 + row) * 256 + gi * 64 + c4) : (f32x4){0.f, 0.f, 0.f, 0.f};
        *(f32x4*)(ul + row * 64 + c4) = v;
    }
    {
        const float* wp = p.pool_w + ((size_t)(l * 4 + gi) * 64) * 64;
#pragma unroll
        for (int i = 0; i < 4; ++i) {
            const int idx = i * 256 + tid, c = idx >> 4, d4 = (idx & 15) * 4;
            const f32x4 v = *(const f32x4*)(wp + c * 64 + d4);
#pragma unroll
            for (int e = 0; e < 4; ++e) wt[(d4 + e) * 72 + c] = f2bf(v[e]);
        }
    }
    __syncthreads();
    {
        const int c = tid & 63, t0 = (tid >> 6) * 16;
        float sum = 0.f;
        for (int k = 0; k < w; ++k) sum += ul[(16 + t0 - k) * 64 + c];
#pragma unroll 4
        for (int i = 0; i < 16; ++i) {
            const int t = t0 + i;
            if (i > 0) sum += ul[(16 + t) * 64 + c] - ul[(16 + t - w) * 64 + c];
            const int sq = s0 + t;
            const float div = (float)(sq + 1 < w ? sq + 1 : w);
            pb[t * 72 + c] = f2bf(sum / div - ul[(16 + t) * 64 + c]);
        }
    }
    __syncthreads();
    {
        f32x4 acc[4];
#pragma unroll
        for (int nt = 0; nt < 4; ++nt) acc[nt] = (f32x4){0.f, 0.f, 0.f, 0.f};
#pragma unroll
        for (int ks = 0; ks < 2; ++ks) {
            const bf16x8 af = *(const bf16x8*)(pb + (wave * 16 + l16) * 72 + ks * 32 + quad * 8);
#pragma unroll
            for (int nt = 0; nt < 4; ++nt) {
                const bf16x8 bfr = *(const bf16x8*)(wt + (nt * 16 + l16) * 72 + ks * 32 + quad * 8);
                acc[nt] = mfma16(bfr, af, acc[nt]);
            }
        }
        const float* sc = p.pool_scale + l * 256 + gi * 64;
        bf16_t* dst = cat + (size_t)(tok0 + wave * 16 + l16) * 1024 + gi * 64;
#pragma unroll
        for (int nt = 0; nt < 4; ++nt) {
            const f32x4 s4 = *(const f32x4*)(sc + nt * 16 + quad * 4);
            const f32x4 o = acc[nt] * s4;
            u32x2 pk; pk.x = pk_bf16(o[0], o[1]); pk.y = pk_bf16(o[2], o[3]);
            *(u32x2*)(dst + nt * 16 + quad * 4) = pk;
        }
    }
    __syncthreads();
}

DEVI void s5_load_u(const float* ussm, int tok0, int G, float* us, int lane) {
    const float* up = ussm + (size_t)(tok0 + lane) * 256 + G * 16;
#pragma unroll
    for (int i = 0; i < 4; ++i) *(f32x4*)(us + lane * 16 + i * 4) = *(const f32x4*)(up + i * 4);
}

DEVI void s5_pass_a(const Params& p, int l, int witem, float* wl) {
    unsigned char* ws = p.ws;
    const int lane = TIDX & 63;
    const int G = witem & 15, k = (witem >> 4) & 127, b = witem >> 11;
    const int sidx = (l * 16 + G) * 64 + lane;
    const float4 a4 = ((const float4*)(ws + OFF_S5A))[sidx];
    f32x2v bb2[16];
    const float* bb = (const float*)(ws + OFF_S5B) + (size_t)sidx * 32;
#pragma unroll
    for (int i = 0; i < 4; ++i) {
        const f32x4 t = *(const f32x4*)(bb + i * 4);
        const f32x4 u = *(const f32x4*)(bb + 16 + i * 4);
#pragma unroll
        for (int e = 0; e < 4; ++e) bb2[i * 4 + e] = (f32x2v){t[e], u[e]};
    }
    float* us = wl;
    s5_load_u((const float*)(ws + OFF_USSM), b * S_ + k * 64, G, us, lane);
    __builtin_amdgcn_fence(__ATOMIC_RELEASE, "wavefront");
    __builtin_amdgcn_wave_barrier();
    __builtin_amdgcn_fence(__ATOMIC_ACQUIRE, "wavefront");
    float hr = 0.f, hi = 0.f;
    for (int t = 0; t < 64; ++t) {
        f32x2v xa = (f32x2v){0.f, 0.f}, xb = (f32x2v){0.f, 0.f};
#pragma unroll
        for (int i = 0; i < 4; ++i) {
            const f32x4 u = *(const f32x4*)(us + t * 16 + i * 4);
            xa += bb2[i * 4] * u[0]; xb += bb2[i * 4 + 1] * u[1]; xa += bb2[i * 4 + 2] * u[2]; xb += bb2[i * 4 + 3] * u[3];
        }
        const float xr = xa[0] + xb[0], xi = xa[1] + xb[1];
        const float nr = a4.x * hr - a4.y * hi + xr, ni = a4.x * hi + a4.y * hr + xi;
        hr = nr; hi = ni;
    }
    float2* E = (float2*)(ws + OFF_E);
    E[((size_t)(b * 128 + k) * 16 + G) * 64 + lane] = make_float2(hr, hi);
    __builtin_amdgcn_wave_barrier();
}

DEVI void phase_m2(const Params& p, int l, unsigned char* smem) {
    constexpr int NCMP = 128, NPOOL = 1024, NS5 = 1024;
    for (int item = blockIdx.x; item < NCMP + NPOOL + NS5; item += gridDim.x) {
        __syncthreads();
        if (item < NCMP) compress_partial(p, l, (item >> 4) & 1, item & 15, item >> 5, (bf16_t*)smem);
        else if (item < NCMP + NPOOL) { const int it = item - NCMP; pool_item(p, l, it >> 2, it & 3, (float*)smem); }
        else { const int it = item - NCMP - NPOOL; const int wv = wave_(); s5_pass_a(p, l, it * 4 + wv, (float*)(smem + wv * 16384)); }
    }
}

DEVI void s5_pass_b(const Params& p, int l, int witem, unsigned char* wlraw) {
    unsigned char* ws = p.ws;
    const int lane = TIDX & 63, l16 = lane & 15, quad = lane >> 4;
    const int G = witem & 15, k = (witem >> 4) & 127, b = witem >> 11;
    const int sidx = (l * 16 + G) * 64 + lane;
    const float4 a4 = ((const float4*)(ws + OFF_S5A))[sidx];
    f32x2v bb2[16];
    const float* bb = (const float*)(ws + OFF_S5B) + (size_t)sidx * 32;
#pragma unroll
    for (int i = 0; i < 4; ++i) {
        const f32x4 t = *(const f32x4*)(bb + i * 4);
        const f32x4 u = *(const f32x4*)(bb + 16 + i * 4);
#pragma unroll
        for (int e = 0; e < 4; ++e) bb2[i * 4 + e] = (f32x2v){t[e], u[e]};
    }
    float* us = (float*)wlraw;
    bf16_t* Hs = (bf16_t*)(wlraw + 4096);
    const int tok0 = b * S_ + k * 64;
    s5_load_u((const float*)(ws + OFF_USSM), tok0, G, us, lane);
    float hr = 0.f, hi = 0.f;
    {
        const float2* E = (const float2*)(ws + OFF_E) + ((size_t)(b * 128) * 16 + G) * 64 + lane;
#pragma unroll 8
        for (int kk = 0; kk < k; ++kk) {
            const float2 e = E[(size_t)kk * 16 * 64];
            const float nr = a4.z * hr - a4.w * hi + e.x, ni = a4.z * hi + a4.w * hr + e.y;
            hr = nr; hi = ni;
        }
    }
    bf16x8 cf[4];
    {
        const float* cre = p.c_re + ((size_t)(l * 16 + G) * 16 + l16) * 64 + quad * 8;
        const float* cim = p.c_im + ((size_t)(l * 16 + G) * 16 + l16) * 64 + quad * 8;
#pragma unroll
        for (int ks = 0; ks < 4; ++ks) {
            const float* sp = (ks < 2 ? cre : cim) + (ks & 1) * 32;
            const float sg = ks < 2 ? 1.f : -1.f;
            const float4 a = *(const float4*)sp, c = *(const float4*)(sp + 4);
            union { bf16x8 v; unsigned u[4]; } cv;
            cv.u[0] = pk_bf16(sg * a.x, sg * a.y); cv.u[1] = pk_bf16(sg * a.z, sg * a.w); cv.u[2] = pk_bf16(sg * c.x, sg * c.y); cv.u[3] = pk_bf16(sg * c.z, sg * c.w);
            cf[ks] = cv.v;
        }
    }
    const float dsk = p.ssm_d[(l * 16 + G) * 16 + l16];
    bf16_t* yg = (bf16_t*)(ws + OFF_YG);
    __builtin_amdgcn_fence(__ATOMIC_RELEASE, "wavefront");
    __builtin_amdgcn_wave_barrier();
    __builtin_amdgcn_fence(__ATOMIC_ACQUIRE, "wavefront");
    for (int half = 0; half < 2; ++half) {
        for (int tt = 0; tt < 32; ++tt) {
            const int t = half * 32 + tt;
            f32x2v xa = (f32x2v){0.f, 0.f}, xb = (f32x2v){0.f, 0.f};
#pragma unroll
            for (int i = 0; i < 4; ++i) {
                const f32x4 u = *(const f32x4*)(us + t * 16 + i * 4);
                xa += bb2[i * 4] * u[0]; xb += bb2[i * 4 + 1] * u[1]; xa += bb2[i * 4 + 2] * u[2]; xb += bb2[i * 4 + 3] * u[3];
            }
            const float xr = xa[0] + xb[0], xi = xa[1] + xb[1];
            const float nr = a4.x * hr - a4.y * hi + xr, ni = a4.x * hi + a4.y * hr + xi;
            hr = nr; hi = ni;
            Hs[tt * 136 + lane] = f2bf(hr);
            Hs[tt * 136 + 64 + lane] = f2bf(hi);
        }
        __builtin_amdgcn_fence(__ATOMIC_RELEASE, "wavefront");
        __builtin_amdgcn_wave_barrier();
        __builtin_amdgcn_fence(__ATOMIC_ACQUIRE, "wavefront");
        f32x4 y[2];
#pragma unroll
        for (int mt = 0; mt < 2; ++mt) {
            y[mt] = (f32x4){0.f, 0.f, 0.f, 0.f};
#pragma unroll
            for (int ks = 0; ks < 4; ++ks) {
                const bf16x8 hf = *(const bf16x8*)(Hs + (mt * 16 + l16) * 136 + ks * 32 + quad * 8);
                y[mt] = mfma16(hf, cf[ks], y[mt]);
            }
        }
#pragma unroll
        for (int mt = 0; mt < 2; ++mt)
#pragma unroll
            for (int r = 0; r < 4; ++r) {
                const int t = half * 32 + mt * 16 + quad * 4 + r;
                const float yy = y[mt][r] + dsk * us[t * 16 + l16];
                yg[(size_t)(tok0 + t) * 256 + G * 16 + l16] = f2bf(gelu_tanh(yy));
            }
        __builtin_amdgcn_fence(__ATOMIC_RELEASE, "wavefront");
        __builtin_amdgcn_wave_barrier();
        __builtin_amdgcn_fence(__ATOMIC_ACQUIRE, "wavefront");
    }
}

constexpr int AT_ROW = 72;
constexpr int AT_TILE = 64 * AT_ROW;
DEVI void attn_item(const Params& p, int bg, int t0, unsigned char* smem) {
    unsigned char* ws = p.ws;
    const int tid = TIDX, lane = tid & 63, wave = wave_(), l16 = lane & 15, quad = lane >> 4;
    const int b = bg >> 1, g = bg & 1, r = l16 & 3;
    float* imp = (float*)(smem + 32768) + wave * 2096;
    float* impe = imp + 1024;
    unsigned* selw = (unsigned*)(imp + 2048);
    unsigned* anyw = selw + 32;
    int tq[2];
    tq[0] = t0 + wave * 8 + (l16 >> 2); tq[1] = tq[0] + 4;
    bf16x8 qf[2][2];
    float g_cmp[2], g_slc[2], g_win[2];
#pragma unroll
    for (int ct = 0; ct < 2; ++ct) {
        const size_t tok = (size_t)b * S_ + tq[ct];
        const bf16_t* qp = (const bf16_t*)(ws + OFF_Q) + tok * 512 + (g * 4 + r) * 64 + quad * 8;
        qf[ct][0] = *(const bf16x8*)qp; qf[ct][1] = *(const bf16x8*)(qp + 32);
        const float* gp = (const float*)(ws + OFF_GATES) + tok * 24 + (g * 4 + r) * 3;
        g_cmp[ct] = gp[0]; g_slc[ct] = gp[1]; g_win[ct] = gp[2];
    }
#pragma unroll
    for (int i = 0; i < 32; ++i) imp[i * 64 + lane] = 0.f;
    const bf16_t* kc = (const bf16_t*)(ws + OFF_KC) + (size_t)bg * 512 * 64;
    const bf16_t* vct = (const bf16_t*)(ws + OFF_VCT) + (size_t)bg * 8 * 4096;
    const bf16_t* ksl = (const bf16_t*)(ws + OFF_KSLC) + (size_t)bg * S_ * 64;
    const bf16_t* vsl = (const bf16_t*)(ws + OFF_VSLCT) + (size_t)bg * 128 * 4096;
    const bf16_t* kwn = (const bf16_t*)(ws + OFF_KWIN) + (size_t)bg * S_ * 64;
    const bf16_t* vwn = (const bf16_t*)(ws + OFF_VWINT) + (size_t)bg * 128 * 4096;
    const int tmax = t0 + 31;
    const int ncb = tmax >= 31 ? (((tmax - 31) >> 4) >> 6) + 1 : 0;
    const int cur = t0 >> 6;
    const int nsl = cur + 1;
    const int jlo = (t0 - 511 > 0 ? t0 - 511 : 0) >> 6;
    const int nwn = cur - jlo + 1;
    const int n1 = ncb, n2 = 2 * ncb, n3 = n2 + nsl, ntot = n3 + nwn;
    auto tile_ptrs = [&](int n, const bf16_t*& kp, const bf16_t*& vp) {
        if (n < n2) { const int c = n < n1 ? n : n - n1; kp = kc + (size_t)c * 4096; vp = vct + (size_t)c * 4096; }
        else if (n < n3) { const int j = n - n2; kp = ksl + (size_t)j * 4096; vp = vsl + (size_t)j * 4096; }
        else { const int j = jlo + (n - n3); kp = kwn + (size_t)j * 4096; vp = vwn + (size_t)j * 4096; }
    };
    unsigned gv0, gv1;
    {
        const int R0 = tid >> 3, R1 = 32 + (tid >> 3);
        gv0 = (unsigned)(R0 * 128 + (((tid & 7) ^ ((R0 >> 1) & 7)) * 16));
        gv1 = (unsigned)(R1 * 128 + (((tid & 7) ^ ((R1 >> 1) & 7)) * 16));
    }
    const unsigned alds0 = (unsigned)(size_t)((LAS unsigned char*)smem) + (unsigned)wave * 1024u;
    {
        const bf16_t *kp, *vp; tile_ptrs(0, kp, vp);
        glds_tile4(gv0, gv1, kp, vp, __builtin_amdgcn_readfirstlane(alds0));
    }
    const int rsw = l16 >> 1;
    f32x4 outacc[2][4], o[2][4];
    float m[2], lsum[2], invl[2];
    f32x4 lacc[2];
    const bf16x8 ones8 = __builtin_bit_cast(bf16x8, (u32x4){0x3f803f80u, 0x3f803f80u, 0x3f803f80u, 0x3f803f80u});
#pragma unroll
    for (int ct = 0; ct < 2; ++ct) {
        m[ct] = NEGBIG; lsum[ct] = 0.f; invl[ct] = 0.f; lacc[ct] = (f32x4){0.f, 0.f, 0.f, 0.f};
#pragma unroll
        for (int i = 0; i < 4; ++i) { outacc[ct][i] = (f32x4){0.f, 0.f, 0.f, 0.f}; o[ct][i] = (f32x4){0.f, 0.f, 0.f, 0.f}; }
    }
    const float NINF = -__builtin_inff();
    auto finalize = [&](const float (&gate)[2], bool normalise) {
#pragma unroll
        for (int ct = 0; ct < 2; ++ct) {
            float sc = gate[ct];
            if (normalise) { const float l = lacc[ct][0]; sc = l > 0.f ? gate[ct] / l : 0.f; }
#pragma unroll
            for (int i = 0; i < 4; ++i) { outacc[ct][i] += o[ct][i] * sc; o[ct][i] = (f32x4){0.f, 0.f, 0.f, 0.f}; }
            m[ct] = NEGBIG; lsum[ct] = 0.f; lacc[ct] = (f32x4){0.f, 0.f, 0.f, 0.f};
        }
    };
    auto trans = [&](const int n) {
        if (n == n1 && n1 > 0) {
#pragma unroll
            for (int ct = 0; ct < 2; ++ct) { float l = lsum[ct]; l += __shfl_xor(l, 16); l += __shfl_xor(l, 32); invl[ct] = l > 0.f ? 1.0f / l : 0.f; }
        }
        if (n == n2) {
            if (n1 > 0) finalize(g_cmp, false);
            else { m[0] = m[1] = NEGBIG; lsum[0] = lsum[1] = 0.f; }
            __builtin_amdgcn_fence(__ATOMIC_RELEASE, "wavefront");
            __builtin_amdgcn_wave_barrier();
            __builtin_amdgcn_fence(__ATOMIC_ACQUIRE, "wavefront");
            const int q8 = lane >> 3, jb = (lane & 7) * 16;
            const int tqq = t0 + wave * 8 + q8;
            float v[16];
#pragma unroll
            for (int i4 = 0; i4 < 4; ++i4) {
                const f32x4 x = *(const f32x4*)(imp + q8 * 128 + jb + i4 * 4);
                const int jm = jb + i4 * 4 - 1;
                const float ep = jm >= 0 ? impe[q8 * 128 + jm] : 0.f;
                const f32x4 ex = (f32x4){ep, impe[q8 * 128 + jm + 1], impe[q8 * 128 + jm + 2], impe[q8 * 128 + jm + 3]};
#pragma unroll
                for (int e = 0; e < 4; ++e) {
                    const int j = jb + i4 * 4 + e;
                    float iv = x[e] + ex[e];
                    const bool forced = (j == 0) || (j == cur) || (j == cur - 1);
                    if (forced) iv += 1e4f;
                    if (64 * j > tqq) iv = NEGBIG;
                    v[i4 * 4 + e] = iv;
                }
            }
            unsigned selbits = 0;
#pragma unroll 1
            for (int round = 0; round < 16; ++round) {
                float bv = v[0]; int bi = 0;
#pragma unroll
                for (int i = 1; i < 16; ++i) { const bool gt = v[i] > bv; bv = gt ? v[i] : bv; bi = gt ? i : bi; }
                int gi = jb + bi;
#define TOPK_STEP(CTRL) { \
                    const float ov = __int_as_float(__builtin_amdgcn_update_dpp(0, __float_as_int(bv), (CTRL), 0xf, 0xf, false)); \
                    const int oi = __builtin_amdgcn_update_dpp(0, gi, (CTRL), 0xf, 0xf, false); \
                    const bool take = (ov > bv) || (ov == bv && oi < gi); \
                    bv = take ? ov : bv; gi = take ? oi : gi; }
                TOPK_STEP(0xB1)
                TOPK_STEP(0x4E)
                TOPK_STEP(0x141)
#undef TOPK_STEP
                const bool mine = (gi >> 4) == (lane & 7);
                const int li = gi & 15;
                if (mine && bv > -1e29f) selbits |= 1u << li;
#pragma unroll
                for (int i = 0; i < 16; ++i) v[i] = (mine && i == li) ? NINF : v[i];
            }
            unsigned wv = selbits << ((lane & 1) * 16);
            wv |= __shfl_xor(wv, 1);
            if ((lane & 1) == 0) selw[q8 * 4 + ((lane & 7) >> 1)] = wv;
            __builtin_amdgcn_fence(__ATOMIC_RELEASE, "wavefront");
            __builtin_amdgcn_wave_barrier();
            __builtin_amdgcn_fence(__ATOMIC_ACQUIRE, "wavefront");
#pragma unroll
            for (int ct = 0; ct < 2; ++ct)
#pragma unroll
                for (int w = 0; w < 4; ++w) {
                    const unsigned a = selw[(ct * 4 + 0) * 4 + w] | selw[(ct * 4 + 1) * 4 + w] | selw[(ct * 4 + 2) * 4 + w] | selw[(ct * 4 + 3) * 4 + w];
                    if (lane == 0) anyw[ct * 4 + w] = a;
                }
            __builtin_amdgcn_fence(__ATOMIC_RELEASE, "wavefront");
            __builtin_amdgcn_wave_barrier();
            __builtin_amdgcn_fence(__ATOMIC_ACQUIRE, "wavefront");
        }
        if (n == n3) finalize(g_slc, true);
    };
    auto body = [&](auto kc, const int n) {
        constexpr int KIND = decltype(kc)::value;
        asm volatile("s_waitcnt vmcnt(0)\n\ts_barrier" ::: "memory");
        if (n + 1 < ntot) {
            const bf16_t *kp, *vp; tile_ptrs(n + 1, kp, vp);
            glds_tile4(gv0, gv1, kp, vp, __builtin_amdgcn_readfirstlane(alds0 + ((n + 1) & 1) * 16384));
        }
        const unsigned char* cK = smem + (n & 1) * 16384;
        const unsigned char* cV = cK + 8192;
        constexpr bool is_p1 = KIND == 0, is_p2 = KIND == 1, is_slc = KIND == 2 || KIND == 4;
        const int jt = is_slc ? n - n2 : jlo + (n - n3);
        const bool elem = KIND == 3 || (is_slc && jt == cur);
        const int wlim = is_slc ? 0x40000000 : 512;
        const int c0 = (is_p1 ? n : n - n1) * 64;
        bool any_act = true;
        if (is_slc && !elem) {
            const unsigned aw = __builtin_amdgcn_readfirstlane(anyw[jt >> 5] | anyw[4 + (jt >> 5)]);
            any_act = (aw >> (jt & 31)) & 1u;
        }
        if (any_act) {
            f32x4 s[2][4];
            {
                bf16x8 k0[4], k1[4];
#pragma unroll
                for (int mt = 0; mt < 4; ++mt) {
                    k0[mt] = *(const bf16x8*)(cK + (mt * 16 + l16) * 128 + ((quad ^ rsw) * 16));
                    k1[mt] = *(const bf16x8*)(cK + (mt * 16 + l16) * 128 + (((4 + quad) ^ rsw) * 16));
                }
#pragma unroll
                for (int mt = 0; mt < 4; ++mt)
#pragma unroll
                    for (int ct = 0; ct < 2; ++ct) s[ct][mt] = mfma16(k0[mt], qf[ct][0], (f32x4){0.f, 0.f, 0.f, 0.f});
#pragma unroll
                for (int mt = 0; mt < 4; ++mt)
#pragma unroll
                    for (int ct = 0; ct < 2; ++ct) s[ct][mt] = mfma16(k1[mt], qf[ct][1], s[ct][mt]);
            }
            if (is_p1) {
                float bm[2];
#pragma unroll
                for (int ct = 0; ct < 2; ++ct) {
                    bm[ct] = NINF;
#pragma unroll
                    for (int mt = 0; mt < 4; ++mt)
#pragma unroll
                        for (int rr = 0; rr < 4; ++rr) {
                            const int c = c0 + mt * 16 + quad * 4 + rr;
                            const float x = (16 * c + 31 <= tq[ct]) ? s[ct][mt][rr] * LOG2E : NINF;
                            s[ct][mt][rr] = x; bm[ct] = fmaxf(bm[ct], x);
                        }
                }
#pragma unroll
                for (int ct = 0; ct < 2; ++ct) bm[ct] = fmaxf(bm[ct], __shfl_xor(bm[ct], 16));
#pragma unroll
                for (int ct = 0; ct < 2; ++ct) bm[ct] = fmaxf(bm[ct], __shfl_xor(bm[ct], 32));
#pragma unroll
                for (int ct = 0; ct < 2; ++ct) {
                    const float mn = fmaxf(m[ct], bm[ct]);
                    float ls = 0.f;
#pragma unroll
                    for (int mt = 0; mt < 4; ++mt)
#pragma unroll
                        for (int rr = 0; rr < 4; ++rr) ls += fast_exp2(s[ct][mt][rr] - mn);
                    lsum[ct] = lsum[ct] * fast_exp2(m[ct] - mn) + ls;
                    m[ct] = mn;
                }
            } else {
                if (is_p2) {
#pragma unroll
                    for (int ct = 0; ct < 2; ++ct) {
                        const int q8 = ct * 4 + (l16 >> 2);
#pragma unroll
                        for (int mt = 0; mt < 4; ++mt) {
#pragma unroll
                            for (int rr = 0; rr < 4; ++rr) {
                                const int c = c0 + mt * 16 + quad * 4 + rr;
                                s[ct][mt][rr] = (16 * c + 31 <= tq[ct]) ? fast_exp2(s[ct][mt][rr] * LOG2E - m[ct]) * invl[ct] : 0.f;
                            }
                            float gs = (s[ct][mt][0] + s[ct][mt][1]) + (s[ct][mt][2] + s[ct][mt][3]);
                            float es = s[ct][mt][3];
                            gs += __int_as_float(__builtin_amdgcn_update_dpp(0, __float_as_int(gs), 0xB1, 0xf, 0xf, false));
                            gs += __int_as_float(__builtin_amdgcn_update_dpp(0, __float_as_int(gs), 0x4E, 0xf, 0xf, false));
                            es += __int_as_float(__builtin_amdgcn_update_dpp(0, __float_as_int(es), 0xB1, 0xf, 0xf, false));
                            es += __int_as_float(__builtin_amdgcn_update_dpp(0, __float_as_int(es), 0x4E, 0xf, 0xf, false));
                            if (r == 0) {
                                const int j = (c0 >> 2) + mt * 4 + quad;
                                imp[q8 * 128 + j] = gs;
                                impe[q8 * 128 + j] = es;
                            }
                        }
                    }
                } else {
                    float bias[2], mr[2], mn[2], ls[2];
#pragma unroll
                    for (int ct = 0; ct < 2; ++ct) {
                        bias[ct] = 0.f; ls[ct] = 0.f; (void)ls[ct];
                        if (is_slc) {
                            const int q8 = ct * 4 + (l16 >> 2);
                            const unsigned w = selw[q8 * 4 + (jt >> 5)];
                            bias[ct] = ((w >> (jt & 31)) & 1u) ? 0.f : NINF;
                        }
                    }
                    if (elem) {
#pragma unroll
                        for (int ct = 0; ct < 2; ++ct) {
                            mr[ct] = NINF;
#pragma unroll
                            for (int mt = 0; mt < 4; ++mt)
#pragma unroll
                                for (int rr = 0; rr < 4; ++rr) {
                                    float x = __builtin_fmaf(s[ct][mt][rr], LOG2E, bias[ct]);
                                    const int dist = tq[ct] - (jt * 64 + mt * 16 + quad * 4 + rr);
                                    x = (dist >= 0 && dist < wlim) ? x : NINF;
                                    s[ct][mt][rr] = x; mr[ct] = fmaxf(mr[ct], x);
                                }
                        }
#pragma unroll
                        for (int ct = 0; ct < 2; ++ct) mr[ct] = fmaxf(mr[ct], __shfl_xor(mr[ct], 16));
#pragma unroll
                        for (int ct = 0; ct < 2; ++ct) mr[ct] = fmaxf(mr[ct], __shfl_xor(mr[ct], 32));
                        bool need = false;
#pragma unroll
                        for (int ct = 0; ct < 2; ++ct) need = need || (fmaxf(m[ct], mr[ct]) - m[ct] > 8.0f);
                        const bool resc = __builtin_amdgcn_ballot_w64(need) != 0;
#pragma unroll
                        for (int ct = 0; ct < 2; ++ct) {
                            mn[ct] = resc ? fmaxf(m[ct], mr[ct]) : m[ct];
#pragma unroll
                            for (int mt = 0; mt < 4; ++mt)
#pragma unroll
                                for (int rr = 0; rr < 4; ++rr) { s[ct][mt][rr] = fast_exp2(s[ct][mt][rr] - mn[ct]); }
                        }
                    } else {
#pragma unroll
                        for (int ct = 0; ct < 2; ++ct) {
                            mr[ct] = fmaxf(fmaxf(s[ct][0][0], s[ct][0][1]), fmaxf(s[ct][0][2], s[ct][0][3]));
#pragma unroll
                            for (int mt = 1; mt < 4; ++mt) mr[ct] = fmaxf(mr[ct], fmaxf(fmaxf(s[ct][mt][0], s[ct][mt][1]), fmaxf(s[ct][mt][2], s[ct][mt][3])));
                        }
#pragma unroll
                        for (int ct = 0; ct < 2; ++ct) mr[ct] = fmaxf(mr[ct], __shfl_xor(mr[ct], 16));
#pragma unroll
                        for (int ct = 0; ct < 2; ++ct) mr[ct] = fmaxf(mr[ct], __shfl_xor(mr[ct], 32));
                        float cand[2];
                        bool need = false;
#pragma unroll
                        for (int ct = 0; ct < 2; ++ct) {
                            cand[ct] = fmaxf(m[ct], __builtin_fmaf(mr[ct], LOG2E, bias[ct]));
                            need = need || (cand[ct] - m[ct] > 8.0f);
                        }
                        const bool resc = __builtin_amdgcn_ballot_w64(need) != 0;
#pragma unroll
                        for (int ct = 0; ct < 2; ++ct) {
                            mn[ct] = resc ? cand[ct] : m[ct];
                            const float nb = bias[ct] - mn[ct];
#pragma unroll
                            for (int mt = 0; mt < 4; ++mt)
#pragma unroll
                                for (int rr = 0; rr < 4; ++rr) { s[ct][mt][rr] = fast_exp2(__builtin_fmaf(s[ct][mt][rr], LOG2E, nb)); }
                        }
                    }
                    float al[2];
#pragma unroll
                    for (int ct = 0; ct < 2; ++ct) {
                        al[ct] = fast_exp2(m[ct] - mn[ct]);
                        m[ct] = mn[ct];
                    }
                    if (__builtin_amdgcn_ballot_w64(al[0] != 1.0f || al[1] != 1.0f)) {
#pragma unroll
                        for (int ct = 0; ct < 2; ++ct)
#pragma unroll
                            for (int i = 0; i < 4; ++i) o[ct][i] *= al[ct];
#pragma unroll
                        for (int ct = 0; ct < 2; ++ct) lacc[ct] *= al[ct];
                    }
                }
#pragma unroll
                for (int kk = 0; kk < 2; ++kk) {
                    u32x4 pb[2];
#pragma unroll
                    for (int ct = 0; ct < 2; ++ct)
                        pb[ct] = (u32x4){pk_bf16(s[ct][2 * kk][0], s[ct][2 * kk][1]), pk_bf16(s[ct][2 * kk][2], s[ct][2 * kk][3]),
                                         pk_bf16(s[ct][2 * kk + 1][0], s[ct][2 * kk + 1][1]), pk_bf16(s[ct][2 * kk + 1][2], s[ct][2 * kk + 1][3])};
                    lacc[0] = mfma16(ones8, __builtin_bit_cast(bf16x8, pb[0]), lacc[0]);
                    lacc[1] = mfma16(ones8, __builtin_bit_cast(bf16x8, pb[1]), lacc[1]);
#pragma unroll
                    for (int dt = 0; dt < 4; ++dt) {
                        const bf16x8 va = *(const bf16x8*)(cV + (dt * 16 + l16) * 128 + (((quad * 2 + kk) ^ rsw) * 16));
                        o[0][dt] = mfma16(va, __builtin_bit_cast(bf16x8, pb[0]), o[0][dt]);
                        o[1][dt] = mfma16(va, __builtin_bit_cast(bf16x8, pb[1]), o[1][dt]);
                    }
                }
            }
        }
    };
    {
        int n = 0;
#pragma unroll 1
        for (; n < n1; ++n) body(std::integral_constant<int, 0>{}, n);
        trans(n1);
#pragma unroll 1
        for (; n < n2; ++n) body(std::integral_constant<int, 1>{}, n);
        if (n2 != n1) trans(n2);
#pragma unroll 1
        for (; n < n3; ++n) body(std::integral_constant<int, 2>{}, n);
        trans(n3);
#pragma unroll 1
        for (; n < ntot; ++n) body(std::integral_constant<int, 3>{}, n);
    }
    finalize(g_win, true);
#pragma unroll
    for (int ct = 0; ct < 2; ++ct) {
        bf16_t* cat = (bf16_t*)(ws + OFF_CAT) + ((size_t)b * S_ + tq[ct]) * 1024 + 256 + (g * 4 + r) * 64 + quad * 4;
#pragma unroll
        for (int dt = 0; dt < 4; ++dt) {
            u32x2 pk; pk.x = pk_bf16(outacc[ct][dt][0], outacc[ct][dt][1]); pk.y = pk_bf16(outacc[ct][dt][2], outacc[ct][dt][3]);
            *(u32x2*)(cat + dt * 16) = pk;
        }
    }
    __syncthreads();
}

DEVI void phase_m3(const Params& p, int l, unsigned char* smem) {
    const int G = gridDim.x, bid = blockIdx.x;
    if ((G & 7) == 0) {
        const int x = bid & 7, bg = x & 3, nb = G >> 3, lb = (bid >> 3) + nb * (x >> 2);
        for (int pi = lb; pi < 128; pi += 2 * nb) {
            attn_item(p, bg, (255 - pi) * 32, smem);
            attn_item(p, bg, pi * 32, smem);
        }
    } else {
        for (int item = bid; item < 1024; item += G) attn_item(p, item & 3, (item >> 2) * 32, smem);
    }
    for (int i = bid; i < 1024; i += G) {
        const int wv = wave_();
        int wi = i * 4 + wv;
        if (i >= 512) { const int k = (wi >> 4) & 127; wi = (wi & ~(127 << 4)) | ((127 - k) << 4); }
        __syncthreads();
        s5_pass_b(p, l, wi, smem + wv * 16384);
    }
}

DEVI void phase_glu(const Params& p, int l, bf16_t* smem) {
    unsigned char* ws = p.ws;
    const bf16_t* A = (const bf16_t*)(ws + OFF_YG);
    const bf16_t* Bt = (const bf16_t*)(ws + OFF_W + (size_t)l * SZ_LAYER + OL_GLUT);
    bf16_t* cat = (bf16_t*)(ws + OFF_CAT);
    const float* gb = p.glu_b + l * 256;
    const int lane = TIDX & 63, wave = wave_(), wr = wave >> 1, wc = wave & 1, l16 = lane & 15, quad = lane >> 4;
    for (int it = 0;; ++it) {
        int tm, tn; if (!tile_map(it, 2, tm, tn)) break;
        f32x4 acc[4][4];
        const bf16_t* Ab = A + (size_t)tm * 128 * 256;
        gemm_tile<true>(acc, [&](int r) { return Ab + (size_t)r * 256; }, 64, Bt + (size_t)tn * 128 * 256, 256, smem);
#pragma unroll
        for (int mi = 0; mi < 4; ++mi)
#pragma unroll
            for (int ni = 0; ni < 4; ++ni) {
                const int row = tm * 128 + wr * 64 + mi * 16 + l16, col = tn * 128 + wc * 64 + ni * 16 + quad * 4;
                const u32x2 yb = *(const u32x2*)(A + (size_t)row * 256 + col);
                const f32x4 gb4 = *(const f32x4*)(gb + col);
                float o[4];
                o[0] = __uint_as_float(yb.x << 16) * sigmoidf_(acc[mi][ni][0] + gb4[0]);
                o[1] = __uint_as_float(yb.x & 0xffff0000u) * sigmoidf_(acc[mi][ni][1] + gb4[1]);
                o[2] = __uint_as_float(yb.y << 16) * sigmoidf_(acc[mi][ni][2] + gb4[2]);
                o[3] = __uint_as_float(yb.y & 0xffff0000u) * sigmoidf_(acc[mi][ni][3] + gb4[3]);
                u32x2 pk; pk.x = pk_bf16(o[0], o[1]); pk.y = pk_bf16(o[2], o[3]);
                *(u32x2*)(cat + (size_t)row * 1024 + 768 + col) = pk;
            }
    }
}


#define XB_TMO      128
#define XB_XCNT(j)  (256  + 64 * (j))
#define XB_XSUB(j)  (1280 + 64 * (j))
#define XB_XGEN(j)  (2304 + 64 * (j))
#define XB_TOP      3328
#define XB_TOPGEN   3392
#define XCD_BAR_WORDS 3456
#define XB_SPIN_CAP (1u << 20)
DEVI unsigned xb_ld(unsigned* p) { return __hip_atomic_load(p, __ATOMIC_RELAXED, __HIP_MEMORY_SCOPE_AGENT); }
DEVI unsigned xb_add(unsigned* p, unsigned v) { return __hip_atomic_fetch_add(p, v, __ATOMIC_RELAXED, __HIP_MEMORY_SCOPE_AGENT); }
DEVI unsigned xb_xcc_id() { return (unsigned)__builtin_amdgcn_s_getreg((3 << 11) | 20) & 0xFu; }
#define XB_SPIN(cond, bar) do { unsigned _sp = 0; while (cond) { __builtin_amdgcn_s_sleep(1); \
    if ((++_sp & 255u) == 0u) { if (xb_ld(&(bar)[XB_TMO])) break; if (_sp > XB_SPIN_CAP) { atomicAdd(&(bar)[XB_TMO], 1u); break; } } } } while (0)
struct XcdBarrier { unsigned* bar; unsigned x; volatile LAS unsigned* st; };
DEVI XcdBarrier xcd_barrier_post(unsigned* bar, volatile LAS unsigned* st) {
    XcdBarrier b; b.bar = bar; b.x = xb_xcc_id(); b.st = st;
    if (threadIdx.x == 0) (void)xb_add(&bar[XB_XCNT(b.x)], 1u);
    return b;
}
DEVI void xcd_barrier_complete(unsigned* bar, unsigned x, unsigned& nloc, unsigned& nx) {
    const unsigned G = gridDim.x * gridDim.y * gridDim.z;
    unsigned sum, cnt, mine, sp = 0u;
    for (;;) {
        sum = 0u; cnt = 0u; mine = 0u;
#pragma unroll
        for (unsigned j = 0; j < 16; ++j) { const unsigned c = xb_ld(&bar[XB_XCNT(j)]); sum += c; cnt += (c > 0u) ? 1u : 0u; mine = (j == x) ? c : mine; }
        if (sum == G) break;
        __builtin_amdgcn_s_sleep(1);
        if ((++sp & 255u) == 0u) { if (xb_ld(&bar[XB_TMO])) break; if (sp > XB_SPIN_CAP) { atomicAdd(&bar[XB_TMO], 1u); break; } }
    }
    nloc = mine > 0u ? mine : 1u; nx = cnt > 0u ? cnt : 1u;
}
DEVI void xcd_barrier(const XcdBarrier& b) {
    asm volatile("s_waitcnt vmcnt(0)" ::: "memory");
    __syncthreads();
    if (threadIdx.x == 0) {
        unsigned* bar = b.bar;
        __builtin_amdgcn_s_waitcnt(0);
        unsigned nloc = b.st[0], nx = b.st[1];
        if (nloc == 0u) { xcd_barrier_complete(bar, b.x, nloc, nx); b.st[0] = nloc; b.st[1] = nx; }
        const unsigned old = xb_add(&bar[XB_XSUB(b.x)], 1u);
        const unsigned gen = old / nloc;
        if (old + 1u == (gen + 1u) * nloc) {
            __builtin_amdgcn_fence(__ATOMIC_RELEASE, "agent");
            asm volatile("s_waitcnt vmcnt(0)" ::: "memory");
            const unsigned og = xb_add(&bar[XB_TOP], 1u);
            const unsigned tg = og / nx;
            if (og + 1u == (tg + 1u) * nx) xb_add(&bar[XB_TOPGEN], 1u);
            else XB_SPIN(xb_ld(&bar[XB_TOPGEN]) == tg, bar);
            __builtin_amdgcn_fence(__ATOMIC_ACQUIRE, "agent");
            xb_add(&bar[XB_XGEN(b.x)], 1u);
            asm volatile("s_waitcnt vmcnt(0)" ::: "memory");
        } else {
            XB_SPIN(xb_ld(&bar[XB_XGEN(b.x)]) == gen, bar);
            __builtin_amdgcn_fence(__ATOMIC_ACQUIRE, "agent");
            asm volatile("s_waitcnt vmcnt(0)" ::: "memory");
        }
    }
    __syncthreads();
}

constexpr int NSUB = 13;
constexpr int NPHASE = 1 + 4 * NSUB;

#ifndef ONLY_SUB
#define ONLY_SUB -1
#endif
#define EN(n) (ONLY_SUB < 0 || ONLY_SUB == (n))
DEVI void run_phase(const Params& p0, int ph, unsigned char* smem) {
    Params p = p0;
    { size_t z = 0; asm volatile("" : "+s"(z)); p.ws = p0.ws + z; }
    if (ph == 0) { if (EN(100)) phase_prologue(p, smem); return; }
    const int l = (ph - 1) / NSUB, sub = (ph - 1) % NSUB;
    unsigned char* ws = p.ws;
    const bf16_t* lw = (const bf16_t*)(ws + OFF_W + (size_t)l * SZ_LAYER);
    switch (sub) {
        case 0: case 10: if (EN(0)) phase_ffn_in(p, l, sub == 10, (bf16_t*)smem); break;
        case 1: case 11: if (EN(1)) {
            const float* res = (l == 0 && sub == 1) ? p.x : nullptr;
            const int lnidx = sub == 1 ? (l > 0 ? (l - 1) * 3 + 2 : 0) : l * 3 + 1;
            const bf16_t* Bt = (const bf16_t*)((const unsigned char*)lw + (sub == 11 ? OL_W2T1 : OL_W2T0));
            phase_gemm_res(p, (const bf16_t*)(ws + OFF_ACT), DFF, Bt, res, lnidx, 0.5f, (bf16_t*)smem);
        } break;
        case 2: case 9: case 12: if (EN(2)) phase_ln(p, l, sub == 2 ? 0 : (sub == 9 ? 1 : 2), l == 3 && sub == 12); break;
        case 3: if (EN(3)) phase_inproj(p, l, (bf16_t*)smem); break;
        case 4: if (EN(4)) phase_m2(p, l, smem); break;
        case 5: if (EN(5)) phase_m2b(p, l, smem); break;
        case 6: if (EN(6)) phase_m3(p, l, smem); break;
        case 7: if (EN(7)) phase_glu(p, l, (bf16_t*)smem); break;
        case 8: if (EN(8)) phase_gemm_res(p, (const bf16_t*)(ws + OFF_CAT), 1024, (const bf16_t*)((const unsigned char*)lw + OL_WOUTT), nullptr, l * 3 + 0, 1.0f, (bf16_t*)smem); break;
    }
}

__global__ void __launch_bounds__(256, 2) mega(Params p, int ph_lo, int ph_hi) {
    __shared__ __attribute__((aligned(16))) unsigned char smem[SMEM_BYTES];
    __shared__ u32x4 xbw;
    if (threadIdx.x == 0) xbw = (u32x4){0u, 0u, 0u, 0u};
    __syncthreads();
    XcdBarrier xb = xcd_barrier_post((unsigned*)(p.ws + OFF_BAR), (volatile LAS unsigned*)&xbw);
    for (int ph = ph_lo; ph < ph_hi; ++ph) {
#ifdef PROBE_DUP
        {
            const int sub = ph == 0 ? 100 : (ph - 1) % NSUB;
            if (sub == PROBE_DUP || (PROBE_DUP == 0 && sub == 10)) { run_phase(p, ph, smem); xcd_barrier(xb); }
        }
#endif
        run_phase(p, ph, smem);
        if (ph + 1 < ph_hi) {
            if (ph_hi < 0) cg::this_grid().sync();
            xcd_barrier(xb);
        }
    }
}

extern "C" void kernel_launch(void* const* d_in, const int* in_sizes, int n_in, void* d_out, int out_size, void* d_ws, size_t ws_size,
                              hipStream_t stream) {
    Params p{};
    const float** pp = (const float**)&p;
    for (int i = 0; i < 27; ++i) pp[i] = (const float*)d_in[i];
    p.out = (float*)d_out;
    p.ws = (unsigned char*)d_ws;
    if (ws_size < WS_TOTAL) fprintf(stderr, "workspace too small: %zu < %zu\n", ws_size, (size_t)WS_TOTAL);
    static int grid_blocks = 0;
    if (!grid_blocks) {
        int dev = 0, cus = 0, per_cu = 0;
        hipGetDevice(&dev);
        hipDeviceGetAttribute(&cus, hipDeviceAttributeMultiprocessorCount, dev);
        hipOccupancyMaxActiveBlocksPerMultiprocessor(&per_cu, mega, 256, 0);
        if (per_cu < 1) per_cu = 1;
        if (per_cu > 2) per_cu = 2;
        grid_blocks = cus * per_cu;
    }
#if MULTI
    for (int ph = 0; ph < NPHASE; ++ph) {
        hipLaunchKernelGGL(mega, dim3(grid_blocks), dim3(256), 0, stream, p, ph, ph + 1);
    }
#else
    (void)hipMemsetAsync((unsigned char*)d_ws + OFF_BAR, 0, BAR_BYTES, stream);
    int lo = 0, hi = NPHASE;
    void* args[] = {&p, &lo, &hi};
    hipError_t e = hipLaunchCooperativeKernel((void*)mega, dim3(grid_blocks), dim3(256), args, 0, stream);
    if (e != hipSuccess) fprintf(stderr, "cooperative launch failed: %s (grid %d)\n", hipGetErrorString(e), grid_blocks);
#endif
}
```

```cpp
#include <hip/hip_runtime.h>
#include <hip/hip_cooperative_groups.h>
#include <stdint.h>
#include <type_traits>
#include <cstdio>
namespace cg = cooperative_groups;

#ifndef MULTI
#define MULTI 0
#endif

#define DEVI __device__ __forceinline__
#define TIDX tid_()
#define LAS __attribute__((address_space(3)))
typedef unsigned short bf16_t;
typedef short bf16x8 __attribute__((ext_vector_type(8)));
typedef short bf16x4 __attribute__((ext_vector_type(4)));
typedef float f32x4 __attribute__((ext_vector_type(4)));
typedef float f32x2v __attribute__((ext_vector_type(2)));
typedef unsigned u32x4 __attribute__((ext_vector_type(4)));
typedef unsigned u32x2 __attribute__((ext_vector_type(2)));

constexpr int T_ = 16384, S_ = 8192, D_ = 1024, DFF = 2816, NIN = 1920, NINSRC = 1816;
constexpr float ALPHA = 1.6817928305074290f;
constexpr float LOG2E = 1.4426950408889634f;
constexpr float NEGBIG = -1e30f;

constexpr size_t SZ_W1T = (size_t)5632 * 1024 * 2, SZ_W2T = (size_t)1024 * 2816 * 2, SZ_WINT = (size_t)NIN * 1024 * 2,
                 SZ_WOUTT = (size_t)1024 * 1024 * 2, SZ_CW1T = (size_t)128 * 2048 * 2, SZ_GLUT = (size_t)256 * 256 * 2;
constexpr size_t OL_W1T0 = 0, OL_W1T1 = OL_W1T0 + SZ_W1T, OL_W2T0 = OL_W1T1 + SZ_W1T, OL_W2T1 = OL_W2T0 + SZ_W2T,
                 OL_WINT = OL_W2T1 + SZ_W2T, OL_WOUTT = OL_WINT + SZ_WINT, OL_CW1K = OL_WOUTT + SZ_WOUTT, OL_CW1V = OL_CW1K + SZ_CW1T,
                 OL_GLUT = OL_CW1V + SZ_CW1T, SZ_LAYER = OL_GLUT + SZ_GLUT;
constexpr size_t OFF_W = 0;
constexpr size_t OFF_COS = OFF_W + 4 * SZ_LAYER, OFF_SIN = OFF_COS + (size_t)S_ * 32 * 4, OFF_CBIAS = OFF_SIN + (size_t)S_ * 32 * 4,
                 OFF_S5A = OFF_CBIAS + 32768, OFF_S5B = OFF_S5A + (size_t)4 * 16 * 64 * 16, OFF_H = OFF_S5B + (size_t)4 * 16 * 64 * 32 * 4,
                 OFF_HB = OFF_H + (size_t)T_ * D_ * 4, OFF_U = OFF_HB + (size_t)T_ * D_ * 2;
constexpr size_t OFF_ACT = OFF_U;
constexpr size_t OFF_Q = OFF_U, OFF_KCMP = OFF_Q + (size_t)T_ * 512 * 2, OFF_VCMP = OFF_KCMP + (size_t)T_ * 128 * 2,
                 OFF_KSLC = OFF_VCMP + (size_t)T_ * 128 * 2, OFF_VSLCT = OFF_KSLC + (size_t)T_ * 128 * 2, OFF_KWIN = OFF_VSLCT + (size_t)T_ * 128 * 2,
                 OFF_VWINT = OFF_KWIN + (size_t)T_ * 128 * 2, OFF_KC = OFF_VWINT + (size_t)T_ * 128 * 2, OFF_VCT = OFF_KC + (size_t)4 * 512 * 64 * 2,
                 OFF_GATES = OFF_VCT + (size_t)4 * 512 * 64 * 2, OFF_UPOOL = OFF_GATES + (size_t)T_ * 24 * 4, OFF_USSM = OFF_UPOOL + (size_t)T_ * 256 * 4,
                 OFF_E = OFF_USSM + (size_t)T_ * 256 * 4, OFF_YG = OFF_E + (size_t)2 * 128 * 16 * 64 * 8, OFF_HIDP = OFF_YG + (size_t)T_ * 256 * 2,
                 OFF_MIXEND = OFF_HIDP + (size_t)8 * 2048 * 128 * 4;
constexpr size_t OFF_ACTEND = OFF_ACT + (size_t)T_ * DFF * 2;
constexpr size_t WS_NEED = (OFF_MIXEND > OFF_ACTEND ? OFF_MIXEND : OFF_ACTEND);
constexpr size_t OFF_CAT = OFF_HB;
constexpr size_t OFF_BAR = WS_NEED, BAR_BYTES = 16384, OFF_STATS = OFF_BAR + BAR_BYTES, WS_TOTAL = OFF_STATS + (size_t)T_ * 8;

struct Params {
    const float *x, *ln_g, *ln_b, *ffn1_in, *ffn1_out, *ffn2_in, *ffn2_out, *w_in, *w_out, *pool_w, *pool_scale, *pe_k, *pe_v,
        *ck_w1, *ck_w2, *cv_w1, *cv_w2, *lam_re, *lam_im, *log_dt, *b_re, *b_im, *c_re, *c_im, *ssm_d, *glu_w, *glu_b;
    float* out;
    unsigned char* ws;
};

DEVI int tid_() { int t = threadIdx.x; asm volatile("" : "+v"(t)); return t; }
DEVI int wave_() { return __builtin_amdgcn_readfirstlane(tid_() >> 6); }
typedef __bf16 bf16x2n __attribute__((ext_vector_type(2)));
DEVI unsigned pk_bf16(float lo, float hi) { const bf16x2n r = __builtin_convertvector((f32x2v){lo, hi}, bf16x2n); return __builtin_bit_cast(unsigned, r); }
DEVI bf16_t f2bf(float f) { return (bf16_t)(pk_bf16(f, 0.f) & 0xffffu); }
DEVI float fast_exp2(float x) { return __builtin_amdgcn_exp2f(x); }
DEVI float rcp_(float x) { return __builtin_amdgcn_rcpf(x); }
DEVI float sigmoidf_(float x) { return rcp_(1.0f + fast_exp2(-x * LOG2E)); }
DEVI float gelu_tanh(float x) {
    const float z = 0.7978845608028654f * (x + 0.044715f * x * x * x);
    const float th = 1.0f - 2.0f * rcp_(1.0f + fast_exp2(z * (2.0f * LOG2E)));
    return 0.5f * x * (1.0f + th);
}
DEVI f32x4 mfma16(bf16x8 a, bf16x8 b, f32x4 c) { return __builtin_amdgcn_mfma_f32_16x16x32_bf16(a, b, c, 0, 0, 0); }

constexpr int LDS_ROW = 72;
constexpr int TILE_ELEMS = 128 * LDS_ROW;
constexpr int SMEM_BYTES = 4 * TILE_ELEMS * 2;

DEVI void glds16(const void* gsrc, unsigned lds_dst) {
    unsigned keep;
    asm volatile("s_mov_b32 %0, m0\n\ts_mov_b32 m0, %2\n\ts_nop 0\n\tglobal_load_lds_dwordx4 %1, off\n\ts_mov_b32 m0, %0"
                 : "=&s"(keep) : "v"(gsrc), "s"(lds_dst) : "memory");
}
DEVI void glds_tile8(const unsigned (&va)[4], const unsigned (&vb)[4], const void* sa, const void* sb, unsigned lds) {
    unsigned keep;
    asm volatile(
        "s_mov_b32 %[keep], m0\n\t"
        "s_mov_b32 m0, %[l]\n\ts_nop 0\n\tglobal_load_lds_dwordx4 %[a0], %[sa]\n\t"
        "s_add_u32 m0, m0, 0x1000\n\ts_nop 0\n\tglobal_load_lds_dwordx4 %[a1], %[sa]\n\t"
        "s_add_u32 m0, m0, 0x1000\n\ts_nop 0\n\tglobal_load_lds_dwordx4 %[a2], %[sa]\n\t"
        "s_add_u32 m0, m0, 0x1000\n\ts_nop 0\n\tglobal_load_lds_dwordx4 %[a3], %[sa]\n\t"
        "s_add_u32 m0, m0, 0x1000\n\ts_nop 0\n\tglobal_load_lds_dwordx4 %[b0], %[sb]\n\t"
        "s_add_u32 m0, m0, 0x1000\n\ts_nop 0\n\tglobal_load_lds_dwordx4 %[b1], %[sb]\n\t"
        "s_add_u32 m0, m0, 0x1000\n\ts_nop 0\n\tglobal_load_lds_dwordx4 %[b2], %[sb]\n\t"
        "s_add_u32 m0, m0, 0x1000\n\ts_nop 0\n\tglobal_load_lds_dwordx4 %[b3], %[sb]\n\t"
        "s_mov_b32 m0, %[keep]"
        : [keep] "=&s"(keep)
        : [a0] "v"(va[0]), [a1] "v"(va[1]), [a2] "v"(va[2]), [a3] "v"(va[3]), [b0] "v"(vb[0]), [b1] "v"(vb[1]), [b2] "v"(vb[2]), [b3] "v"(vb[3]),
          [sa] "s"(sa), [sb] "s"(sb), [l] "s"(lds)
        : "memory", "scc");
}
DEVI void glds_tile4(unsigned v0, unsigned v1, const void* sk, const void* sv, unsigned lds) {
    unsigned keep;
    asm volatile(
        "s_mov_b32 %[keep], m0\n\t"
        "s_mov_b32 m0, %[l]\n\ts_nop 0\n\tglobal_load_lds_dwordx4 %[a0], %[sk]\n\t"
        "s_add_u32 m0, m0, 0x1000\n\ts_nop 0\n\tglobal_load_lds_dwordx4 %[a1], %[sk]\n\t"
        "s_add_u32 m0, m0, 0x1000\n\ts_nop 0\n\tglobal_load_lds_dwordx4 %[a0], %[sv]\n\t"
        "s_add_u32 m0, m0, 0x1000\n\ts_nop 0\n\tglobal_load_lds_dwordx4 %[a1], %[sv]\n\t"
        "s_mov_b32 m0, %[keep]"
        : [keep] "=&s"(keep)
        : [a0] "v"(v0), [a1] "v"(v1), [sk] "s"(sk), [sv] "s"(sv), [l] "s"(lds)
        : "memory", "scc");
}
template <bool SWAP, typename RowPtr>
DEVI void gemm_tile(f32x4 (&acc)[4][4], RowPtr rowptr, int kstepA, const bf16_t* __restrict__ Btile, int K, bf16_t* smem, int ldb = 0, bool first_issued = false) {
    if (ldb == 0) ldb = K;
    const int tid = TIDX, lane = tid & 63, wave = wave_(), wr = wave >> 1, wc = wave & 1, l16 = lane & 15, quad = lane >> 4;
#pragma unroll
    for (int i = 0; i < 4; ++i)
#pragma unroll
        for (int j = 0; j < 4; ++j) acc[i][j] = (f32x4){0.f, 0.f, 0.f, 0.f};
    const bf16_t* a0p = rowptr(0);
    unsigned va[4], vb[4];
#pragma unroll
    for (int j = 0; j < 4; ++j) {
        const int R = j * 32 + (tid >> 3), c = (tid & 7) ^ ((R >> 1) & 7);
        va[j] = (unsigned)((const unsigned char*)(rowptr(R) + c * 8) - (const unsigned char*)a0p);
        vb[j] = (unsigned)(((size_t)R * ldb + c * 8) * 2);
    }
    unsigned char* sbase = (unsigned char*)smem;
    const int nk = K >> 6;
    const unsigned lds0 = (unsigned)(size_t)((LAS unsigned char*)sbase) + (unsigned)wave * 1024u;
    auto issue = [&](int kt, int st) {
        glds_tile8(va, vb, a0p + (size_t)kt * kstepA, Btile + (size_t)kt * 64, __builtin_amdgcn_readfirstlane(lds0 + st * 32768));
    };
    const int sw0 = (quad ^ (l16 >> 1)) * 16;
    const int aoffb = (wr * 64 + l16) * 128, boffb = 16384 + (wc * 64 + l16) * 128;
    if (!first_issued) issue(0, 0);
#pragma unroll 1
    for (int kt = 0; kt < nk; ++kt) {
        asm volatile("s_waitcnt vmcnt(0)\n\ts_barrier" ::: "memory");
        if (kt + 1 < nk) issue(kt + 1, (kt + 1) & 1);
        const unsigned char* cs = sbase + (kt & 1) * 32768;
        bf16x8 af0[4], bf0[4], af1[4], bf1[4];
#pragma unroll
        for (int i = 0; i < 4; ++i) { af0[i] = *(const bf16x8*)(cs + aoffb + i * 2048 + sw0); bf0[i] = *(const bf16x8*)(cs + boffb + i * 2048 + sw0); }
#pragma unroll
        for (int i = 0; i < 4; ++i) { af1[i] = *(const bf16x8*)(cs + aoffb + i * 2048 + (sw0 ^ 64)); bf1[i] = *(const bf16x8*)(cs + boffb + i * 2048 + (sw0 ^ 64)); }
        __builtin_amdgcn_sched_barrier(0);
#pragma unroll
        for (int i = 0; i < 4; ++i)
#pragma unroll
            for (int j = 0; j < 4; ++j) acc[i][j] = SWAP ? mfma16(bf0[j], af0[i], acc[i][j]) : mfma16(af0[i], bf0[j], acc[i][j]);
        __builtin_amdgcn_sched_barrier(0);
#pragma unroll
        for (int i = 0; i < 4; ++i)
#pragma unroll
            for (int j = 0; j < 4; ++j) acc[i][j] = SWAP ? mfma16(bf1[j], af1[i], acc[i][j]) : mfma16(af1[i], bf1[j], acc[i][j]);
    }
    __syncthreads();
}

DEVI void gemm_issue0(const bf16_t* Ab, int lda, const bf16_t* Btile, int ldb, bf16_t* smem) {
    const int tid = TIDX, wave = wave_();
    const unsigned lds0 = (unsigned)(size_t)((LAS unsigned char*)smem) + (unsigned)wave * 1024u;
    unsigned va[4], vb[4];
#pragma unroll
    for (int j = 0; j < 4; ++j) {
        const int R = j * 32 + (tid >> 3), c = (tid & 7) ^ ((R >> 1) & 7);
        va[j] = (unsigned)(((size_t)R * lda + c * 8) * 2);
        vb[j] = (unsigned)(((size_t)R * ldb + c * 8) * 2);
    }
    glds_tile8(va, vb, Ab, Btile, __builtin_amdgcn_readfirstlane(lds0));
}

DEVI bool tile_map(int it, int NTN, int& tm, int& tn) {
    const int G = gridDim.x;
    if ((G & 7) != 0) { const int t = blockIdx.x + it * G; if (t >= 128 * NTN) return false; tm = t / NTN; tn = t % NTN; return true; }
    const int x = blockIdx.x & 7, nb = G >> 3, q = it * nb + (blockIdx.x >> 3);
    if (q >= 16 * NTN) return false;
    const int full = NTN >> 3;
    int chunk, qq, w;
    if (q < full * 128) { chunk = q >> 7; qq = q & 127; w = 8; } else { chunk = full; qq = q - full * 128; w = NTN & 7; }
    tm = x * 16 + qq / w; tn = chunk * 8 + qq % w;
    return true;
}

DEVI int win_src_col(int n) { return n < 1536 ? n : (n < 1792 ? 1560 + (n - 1536) : (n < 1816 ? 1536 + (n - 1792) : -1)); }
DEVI int swiglu_src_col(int n) { const int t16 = n >> 4, pair = t16 >> 1, up = t16 & 1; return up * DFF + pair * 16 + (n & 15); }

DEVI void transpose_tile(const float* __restrict__ W, int Nsrc, bf16_t* __restrict__ out, int K, int perm, int tk, int tn, float* tl) {
    const int tid = TIDX;
    {
        const int n4 = (tid & 15) * 4, kr = tid >> 4;
        const int n = tn * 64 + n4;
        const int sc = perm == 1 ? swiglu_src_col(n) : (perm == 2 ? win_src_col(n) : n);
        f32x4 v[4];
#pragma unroll
        for (int i = 0; i < 4; ++i)
            v[i] = sc >= 0 ? *(const f32x4*)(W + (size_t)(tk * 64 + kr + 16 * i) * Nsrc + sc) : (f32x4){0.f, 0.f, 0.f, 0.f};
#pragma unroll
        for (int i = 0; i < 4; ++i)
#pragma unroll
            for (int e = 0; e < 4; ++e) tl[(kr + 16 * i) * 65 + n4 + e] = v[i][e];
    }
    __syncthreads();
    {
        const int k8 = (tid & 7) * 8, nr = tid >> 3;
#pragma unroll
        for (int i = 0; i < 2; ++i) {
            const int nn = nr + 32 * i;
            u32x4 pk;
            pk.x = pk_bf16(tl[(k8 + 0) * 65 + nn], tl[(k8 + 1) * 65 + nn]); pk.y = pk_bf16(tl[(k8 + 2) * 65 + nn], tl[(k8 + 3) * 65 + nn]);
            pk.z = pk_bf16(tl[(k8 + 4) * 65 + nn], tl[(k8 + 5) * 65 + nn]); pk.w = pk_bf16(tl[(k8 + 6) * 65 + nn], tl[(k8 + 7) * 65 + nn]);
            *(u32x4*)(out + (size_t)(tn * 64 + nn) * K + tk * 64 + k8) = pk;
        }
    }
    __syncthreads();
}

DEVI void dsincos(double x, double& s, double& c) {
    const double TWO_PI = 6.283185307179586476925;
    const double k = rint(x / TWO_PI);
    double r = fma(-k, TWO_PI, x);
    r = fma(-k, 2.4492935982947064e-16, r);
    const double y = r * 0.125, y2 = y * y;
    double sn = 1.0, cs = 1.0;
    sn = y * (1.0 + y2 * (-1.0 / 6 + y2 * (1.0 / 120 + y2 * (-1.0 / 5040 + y2 * (1.0 / 362880 + y2 * (-1.0 / 39916800 + y2 * (1.0 / 6227020800.0)))))));
    cs = 1.0 + y2 * (-0.5 + y2 * (1.0 / 24 + y2 * (-1.0 / 720 + y2 * (1.0 / 40320 + y2 * (-1.0 / 3628800 + y2 * (1.0 / 479001600.0 + y2 * (-1.0 / 87178291200.0)))))));
#pragma unroll
    for (int i = 0; i < 3; ++i) { const double s2 = 2.0 * sn * cs, c2 = cs * cs - sn * sn; sn = s2; cs = c2; }
    s = sn; c = cs;
}

DEVI void phase_prologue(const Params& p, unsigned char* smem_raw) {
    unsigned char* ws = p.ws;
    float* tl = (float*)smem_raw;
    constexpr int NTL = 5104, NT_W = 4 * NTL, NHB = 2048, NCS = 256, NCB = 64, NS5 = 64;
    constexpr int NSMALL = NCS + NCB + NS5;
    constexpr int TOTAL = NT_W + NHB + NCS + NCB + NS5;
    const int tid = TIDX;
    for (int item0 = blockIdx.x; item0 < TOTAL; item0 += gridDim.x) {
        const int item = item0 < NSMALL ? item0 + NT_W + NHB : item0 - NSMALL;
        if (item < NT_W) {
            const int l = item / NTL;
            int r = item % NTL;
            const float* W; bf16_t* out; int K, Nsrc, ntn, perm = 0;
            unsigned char* lw = ws + OFF_W + (size_t)l * SZ_LAYER;
            if (r < 1408) { W = p.ffn1_in + (size_t)l * 1024 * 5632; out = (bf16_t*)(lw + OL_W1T0); K = 1024; Nsrc = 5632; ntn = 88; perm = 1; }
            else if (r < 2816) { r -= 1408; W = p.ffn2_in + (size_t)l * 1024 * 5632; out = (bf16_t*)(lw + OL_W1T1); K = 1024; Nsrc = 5632; ntn = 88; perm = 1; }
            else if (r < 3520) { r -= 2816; W = p.ffn1_out + (size_t)l * 2816 * 1024; out = (bf16_t*)(lw + OL_W2T0); K = 2816; Nsrc = 1024; ntn = 16; }
            else if (r < 4224) { r -= 3520; W = p.ffn2_out + (size_t)l * 2816 * 1024; out = (bf16_t*)(lw + OL_W2T1); K = 2816; Nsrc = 1024; ntn = 16; }
            else if (r < 4704) { r -= 4224; W = p.w_in + (size_t)l * 1024 * NINSRC; out = (bf16_t*)(lw + OL_WINT); K = 1024; Nsrc = NINSRC; ntn = 30; perm = 2; }
            else if (r < 4960) { r -= 4704; W = p.w_out + (size_t)l * 1024 * 1024; out = (bf16_t*)(lw + OL_WOUTT); K = 1024; Nsrc = 1024; ntn = 16; }
            else if (r < 5024) { r -= 4960; W = p.ck_w1 + (size_t)l * 2048 * 128; out = (bf16_t*)(lw + OL_CW1K); K = 2048; Nsrc = 128; ntn = 2; }
            else if (r < 5088) { r -= 5024; W = p.cv_w1 + (size_t)l * 2048 * 128; out = (bf16_t*)(lw + OL_CW1V); K = 2048; Nsrc = 128; ntn = 2; }
            else { r -= 5088; W = p.glu_w + (size_t)l * 256 * 256; out = (bf16_t*)(lw + OL_GLUT); K = 256; Nsrc = 256; ntn = 4; }
            transpose_tile(W, Nsrc, out, K, perm, r / ntn, r % ntn, tl);
        } else if (item < NT_W + NHB) {
            const int it = item - NT_W;
            const float* src = p.x + (size_t)it * 8192;
            bf16_t* dst = (bf16_t*)(ws + OFF_HB) + (size_t)it * 8192;
#pragma unroll
            for (int i = 0; i < 4; ++i) {
                const int e = (i * 256 + tid) * 8;
                const float4 a = *(const float4*)(src + e), b = *(const float4*)(src + e + 4);
                uint4 o; o.x = pk_bf16(a.x, a.y); o.y = pk_bf16(a.z, a.w); o.z = pk_bf16(b.x, b.y); o.w = pk_bf16(b.z, b.w);
                *(uint4*)(dst + e) = o;
            }
        } else if (item < NT_W + NHB + NCS) {
            const int it = item - NT_W - NHB;
            float* ct = (float*)(ws + OFF_COS); float* st = (float*)(ws + OFF_SIN);
#pragma unroll
            for (int i = 0; i < 4; ++i) {
                const int e = it * 1024 + i * 256 + tid;
                const int s = e >> 5, d = e & 31;
                const float inv = 1.0f / powf(10000.0f, (float)(2 * d) / 64.0f);
                const float ang = (float)s * inv;
                double sn, cs; dsincos((double)ang, sn, cs);
                ct[e] = (float)cs; st[e] = (float)sn;
            }
        } else if (item < NT_W + NHB + NCS + NCB) {
            const int it = item - NT_W - NHB - NCS;
            const int job = it >> 3, sl = it & 7, l = job >> 1, kv = job & 1;
            const float* pe = (kv ? p.pe_v : p.pe_k) + (size_t)l * 2048;
            const float* w1 = (kv ? p.cv_w1 : p.ck_w1) + (size_t)l * 2048 * 128;
            const int n = tid & 127, half = tid >> 7;
            float s = 0.f;
            const int k0 = sl * 256 + half * 128;
#pragma unroll 16
            for (int k = k0; k < k0 + 128; ++k) s += pe[k] * w1[(size_t)k * 128 + n];
            __syncthreads();
            if (half) tl[n] = s;
            __syncthreads();
            if (!half) ((float*)(ws + OFF_CBIAS))[it * 128 + n] = s + tl[n];
            __syncthreads();
        } else {
            const int it = item - NT_W - NHB - NCS - NCB;
            if (tid < 64) {
                const int sidx = it * 64 + tid;
                const double dt = exp((double)p.log_dt[it]);
                const double lr = p.lam_re[sidx], li = p.lam_im[sidx];
                const double mag = exp(lr * dt);
                double sn, cs; dsincos(li * dt, sn, cs);
                const double ar = mag * cs, ai = mag * sn;
                const double den = lr * lr + li * li;
                const double fr = ((ar - 1.0) * lr + ai * li) / den, fi = (ai * lr - (ar - 1.0) * li) / den;
                const double magL = exp(lr * dt * 64.0);
                double snL, csL; dsincos(li * dt * 64.0, snL, csL);
                float4 a4; a4.x = (float)ar; a4.y = (float)ai; a4.z = (float)(magL * csL); a4.w = (float)(magL * snL);
                ((float4*)(ws + OFF_S5A))[sidx] = a4;
                float* bb = (float*)(ws + OFF_S5B) + (size_t)sidx * 32;
                for (int c = 0; c < 16; ++c) {
                    const double br = p.b_re[(size_t)sidx * 16 + c], bi = p.b_im[(size_t)sidx * 16 + c];
                    bb[c] = (float)(fr * br - fi * bi);
                    bb[16 + c] = (float)(fr * bi + fi * br);
                }
            }
        }
    }
}

DEVI void phase_ffn_in(const Params& p, int l, int which, bf16_t* smem) {
    unsigned char* ws = p.ws;
    const bf16_t* A = (const bf16_t*)(ws + OFF_HB);
    const bf16_t* Bt = (const bf16_t*)(ws + OFF_W + (size_t)l * SZ_LAYER + (which ? OL_W1T1 : OL_W1T0));
    bf16_t* act = (bf16_t*)(ws + OFF_ACT);
    const int lane = TIDX & 63, wave = wave_(), wr = wave >> 1, wc = wave & 1, l16 = lane & 15, quad = lane >> 4;
    int tm, tn;
    bool have = tile_map(0, 44, tm, tn);
    if (have) gemm_issue0(A + (size_t)tm * 128 * 1024, 1024, Bt + (size_t)tn * 128 * 1024, 1024, smem);
    for (int it = 0; have; ++it) {
        f32x4 acc[4][4];
        const bf16_t* Ab = A + (size_t)tm * 128 * 1024;
        gemm_tile<true>(acc, [&](int r) { return Ab + (size_t)r * 1024; }, 64, Bt + (size_t)tn * 128 * 1024, 1024, smem, 0, true);
        int tm2 = 0, tn2 = 0;
        const bool have2 = tile_map(it + 1, 44, tm2, tn2);
        if (have2) gemm_issue0(A + (size_t)tm2 * 128 * 1024, 1024, Bt + (size_t)tn2 * 128 * 1024, 1024, smem);
        const int colb = (tn * 128 + wc * 64) >> 1;
#pragma unroll
        for (int mi = 0; mi < 4; ++mi)
#pragma unroll
            for (int pp = 0; pp < 2; ++pp) {
                float v[4];
#pragma unroll
                for (int r = 0; r < 4; ++r) { const float g = acc[mi][2 * pp][r], u = acc[mi][2 * pp + 1][r]; v[r] = g * u * rcp_(1.0f + fast_exp2(-g * LOG2E)); }
                const int row = tm * 128 + wr * 64 + mi * 16 + l16;
                u32x2 pk; pk.x = pk_bf16(v[0], v[1]); pk.y = pk_bf16(v[2], v[3]);
                *(u32x2*)(act + (size_t)row * DFF + colb + pp * 16 + quad * 4) = pk;
            }
        tm = tm2; tn = tn2; have = have2;
    }
}

DEVI void phase_gemm_res(const Params& p, const bf16_t* A, int K, const bf16_t* Bt, const float* xraw, int lnidx, float bscale, bf16_t* smem) {
    float* hbuf = (float*)(p.ws + OFF_H);
    const f32x2v* stats = (const f32x2v*)(p.ws + OFF_STATS);
    const float* lg = p.ln_g + (size_t)lnidx * D_;
    const float* lb = p.ln_b + (size_t)lnidx * D_;
    const int lane = TIDX & 63, wave = wave_(), wr = wave >> 1, wc = wave & 1, l16 = lane & 15, quad = lane >> 4;
    int tm, tn;
    bool have = tile_map(0, 8, tm, tn);
    if (have) gemm_issue0(A + (size_t)tm * 128 * K, K, Bt + (size_t)tn * 128 * K, K, smem);
    for (int it = 0; have; ++it) {
        f32x4 acc[4][4];
        const bf16_t* Ab = A + (size_t)tm * 128 * K;
        gemm_tile<true>(acc, [&](int r) { return Ab + (size_t)r * K; }, 64, Bt + (size_t)tn * 128 * K, K, smem, 0, true);
        int tm2 = 0, tn2 = 0;
        const bool have2 = tile_map(it + 1, 8, tm2, tn2);
        if (have2) gemm_issue0(A + (size_t)tm2 * 128 * K, K, Bt + (size_t)tn2 * 128 * K, K, smem);
        if (xraw) {
#pragma unroll
            for (int mi = 0; mi < 4; ++mi)
#pragma unroll
                for (int ni = 0; ni < 4; ++ni) {
                    const size_t idx = (size_t)(tm * 128 + wr * 64 + mi * 16 + l16) * D_ + tn * 128 + wc * 64 + ni * 16 + quad * 4;
                    const f32x4 rv = *(const f32x4*)(xraw + idx);
                    *(f32x4*)(hbuf + idx) = rv * ALPHA + acc[mi][ni] * bscale;
                }
        } else {
            f32x4 g4[4], b4[4];
#pragma unroll
            for (int ni = 0; ni < 4; ++ni) {
                const int col = tn * 128 + wc * 64 + ni * 16 + quad * 4;
                g4[ni] = *(const f32x4*)(lg + col) * ALPHA; b4[ni] = *(const f32x4*)(lb + col) * ALPHA;
            }
#pragma unroll
            for (int mi = 0; mi < 4; ++mi) {
                const int row = tm * 128 + wr * 64 + mi * 16 + l16;
                const f32x2v st = stats[row];
#pragma unroll
                for (int ni = 0; ni < 4; ++ni) {
                    const size_t idx = (size_t)row * D_ + tn * 128 + wc * 64 + ni * 16 + quad * 4;
                    const f32x4 rv = *(const f32x4*)(hbuf + idx);
                    *(f32x4*)(hbuf + idx) = ((rv - st[0]) * st[1]) * g4[ni] + b4[ni] + acc[mi][ni] * bscale;
                }
            }
        }
        tm = tm2; tn = tn2; have = have2;
    }
}

DEVI void phase_ln(const Params& p, int l, int which, bool last) {
    float* hbuf = (float*)(p.ws + OFF_H);
    bf16_t* hb = (bf16_t*)(p.ws + OFF_HB);
    float* dst = last ? p.out : hbuf;
    const float* g = p.ln_g + (size_t)(l * 3 + which) * D_;
    const float* b = p.ln_b + (size_t)(l * 3 + which) * D_;
    const int lane = TIDX & 63, wave = wave_();
    const int stride = gridDim.x * 4;
    int row = blockIdx.x * 4 + wave;
    f32x4 nx[4];
    if (row < T_) {
#pragma unroll
        for (int i = 0; i < 4; ++i) nx[i] = *(const f32x4*)(hbuf + (size_t)row * D_ + i * 256 + lane * 4);
    }
    for (; row < T_; row += stride) {
        f32x4 v[4];
#pragma unroll
        for (int i = 0; i < 4; ++i) v[i] = nx[i];
        const int rn = row + stride < T_ ? row + stride : row;
#pragma unroll
        for (int i = 0; i < 4; ++i) nx[i] = *(const f32x4*)(hbuf + (size_t)rn * D_ + i * 256 + lane * 4);
        float s = 0.f;
#pragma unroll
        for (int i = 0; i < 4; ++i) s += (v[i][0] + v[i][1]) + (v[i][2] + v[i][3]);
#pragma unroll
        for (int o = 32; o > 0; o >>= 1) s += __shfl_xor(s, o);
        const float mu = s * (1.0f / 1024.0f);
        float q = 0.f;
#pragma unroll
        for (int i = 0; i < 4; ++i) { const f32x4 d = v[i] - mu; q += (d[0] * d[0] + d[1] * d[1]) + (d[2] * d[2] + d[3] * d[3]); }
#pragma unroll
        for (int o = 32; o > 0; o >>= 1) q += __shfl_xor(q, o);
        const float rstd = rsqrtf(q * (1.0f / 1024.0f) + 1e-5f);
#pragma unroll
        for (int i = 0; i < 4; ++i) {
            const int c0 = i * 256 + lane * 4;
            const f32x4 gg = *(const f32x4*)(g + c0), bb = *(const f32x4*)(b + c0);
            const f32x4 o = (v[i] - mu) * rstd * gg + bb;
            if (last) *(f32x4*)(dst + (size_t)row * D_ + c0) = o;
            else { u32x2 pk; pk.x = pk_bf16(o[0], o[1]); pk.y = pk_bf16(o[2], o[3]); *(u32x2*)(hb + (size_t)row * D_ + c0) = pk; }
        }
        if (!last && lane == 0) ((f32x2v*)(p.ws + OFF_STATS))[row] = (f32x2v){mu, rstd};
    }
}

DEVI void phase_inproj(const Params& p, int l, bf16_t* smem) {
    unsigned char* ws = p.ws;
    const bf16_t* A = (const bf16_t*)(ws + OFF_HB);
    const bf16_t* Bt = (const bf16_t*)(ws + OFF_W + (size_t)l * SZ_LAYER + OL_WINT);
    const float* cosT = (const float*)(ws + OFF_COS);
    const float* sinT = (const float*)(ws + OFF_SIN);
    bf16_t* qo = (bf16_t*)(ws + OFF_Q);
    float* upool = (float*)(ws + OFF_UPOOL);
    float* ussm = (float*)(ws + OFF_USSM);
    float* gates = (float*)(ws + OFF_GATES);
    const int lane = TIDX & 63, wave = wave_(), wr = wave >> 1, wc = wave & 1, l16 = lane & 15, quad = lane >> 4;
    for (int it = 0;; ++it) {
        int tm, tn; if (!tile_map(it, 15, tm, tn)) break;
        f32x4 acc[4][4];
        const bf16_t* Ab = A + (size_t)tm * 128 * 1024;
        const int cb = tn * 128 + wc * 64;
        const int row0 = tm * 128 + wr * 64;
        if (tn == 9 || tn == 11) {
            gemm_tile<false>(acc, [&](int r) { return Ab + (size_t)r * 1024; }, 64, Bt + (size_t)tn * 128 * 1024, 1024, smem);
            const int g = ((cb - 768) >> 6) & 1;
            bf16_t* dst = (bf16_t*)(ws + (tn == 9 ? OFF_VSLCT : OFF_VWINT));
#pragma unroll
            for (int mi = 0; mi < 4; ++mi) {
                const int tok = row0 + mi * 16 + quad * 4, s = tok & (S_ - 1), b = tok >> 13;
                bf16_t* bp = dst + ((size_t)(b * 2 + g) * 128 + (s >> 6)) * 4096 + (((s >> 2) & 3) * 16 + ((s >> 4) & 3) * 4);
#pragma unroll
                for (int ni = 0; ni < 4; ++ni) {
                    u32x2 pk; pk.x = pk_bf16(acc[mi][ni][0], acc[mi][ni][1]); pk.y = pk_bf16(acc[mi][ni][2], acc[mi][ni][3]);
                    *(u32x2*)(bp + (ni * 16 + l16) * 64) = pk;
                }
            }
            continue;
        }
        gemm_tile<true>(acc, [&](int r) { return Ab + (size_t)r * 1024; }, 64, Bt + (size_t)tn * 128 * 1024, 1024, smem);
        if (cb < 256 || (cb >= 1536 && cb < 1792)) {
            float* dst = cb < 256 ? (upool + cb) : (ussm + (cb - 1536));
#pragma unroll
            for (int mi = 0; mi < 4; ++mi)
#pragma unroll
                for (int ni = 0; ni < 4; ++ni) *(f32x4*)(dst + (size_t)(row0 + mi * 16 + l16) * 256 + ni * 16 + quad * 4) = acc[mi][ni];
        } else if (cb < 1536) {
            const bool isq = cb < 768;
            const int kvi = isq ? -1 : (cb - 768) >> 7, g = isq ? 0 : ((cb - 768) >> 6) & 1;
#pragma unroll
            for (int mi = 0; mi < 4; ++mi) {
                const int tok = row0 + mi * 16 + l16, s = tok & (S_ - 1), b = tok >> 13;
                bf16_t* base;
                if (isq) base = qo + (size_t)tok * 512 + ((cb - 256) >> 6) * 64;
                else if (kvi == 0) base = (bf16_t*)(ws + OFF_KCMP) + (size_t)tok * 128 + g * 64;
                else if (kvi == 1) base = (bf16_t*)(ws + OFF_VCMP) + (size_t)tok * 128 + g * 64;
                else base = (bf16_t*)(ws + (kvi == 2 ? OFF_KSLC : OFF_KWIN)) + ((size_t)(b * 2 + g) * S_ + s) * 64;
                if (kvi == 1) {
#pragma unroll
                    for (int ni = 0; ni < 4; ++ni) {
                        u32x2 pk; pk.x = pk_bf16(acc[mi][ni][0], acc[mi][ni][1]); pk.y = pk_bf16(acc[mi][ni][2], acc[mi][ni][3]);
                        *(u32x2*)(base + ni * 16 + quad * 4) = pk;
                    }
                } else {
                    const float sc = isq ? 0.125f : 1.0f;
#pragma unroll
                    for (int ni = 0; ni < 2; ++ni) {
                        const int d0 = ni * 16 + quad * 4;
                        const f32x4 c4 = *(const f32x4*)(cosT + s * 32 + d0), s4 = *(const f32x4*)(sinT + s * 32 + d0);
                        const f32x4 x1 = acc[mi][ni], x2 = acc[mi][ni + 2];
                        const f32x4 o1 = (x1 * c4 - x2 * s4) * sc, o2 = (x2 * c4 + x1 * s4) * sc;
                        u32x2 p1, p2;
                        p1.x = pk_bf16(o1[0], o1[1]); p1.y = pk_bf16(o1[2], o1[3]);
                        p2.x = pk_bf16(o2[0], o2[1]); p2.y = pk_bf16(o2[2], o2[3]);
                        *(u32x2*)(base + d0) = p1;
                        *(u32x2*)(base + d0 + 32) = p2;
                    }
                }
            }
        } else if (cb == 1792) {
#pragma unroll
            for (int mi = 0; mi < 4; ++mi)
#pragma unroll
                for (int ni = 0; ni < 2; ++ni) {
                    const int c0 = ni * 16 + quad * 4;
                    if (c0 < 24) {
                        f32x4 gv;
#pragma unroll
                        for (int r = 0; r < 4; ++r) gv[r] = sigmoidf_(acc[mi][ni][r]);
                        *(f32x4*)(gates + (size_t)(row0 + mi * 16 + l16) * 24 + c0) = gv;
                    }
                }
        }
    }
}

DEVI void compress_partial(const Params& p, int l, int kv, int tmc, int ks, bf16_t* smem) {
    unsigned char* ws = p.ws;
    const bf16_t* src = (const bf16_t*)(ws + (kv ? OFF_VCMP : OFF_KCMP));
    const bf16_t* Bt = (const bf16_t*)(ws + OFF_W + (size_t)l * SZ_LAYER + (kv ? OL_CW1V : OL_CW1K)) + ks * 512;
    float* hp = (float*)(ws + OFF_HIDP) + ((size_t)(ks * 2 + kv) * 2048 + tmc * 128) * 128;
    const int tid = TIDX, lane = tid & 63, wave = wave_(), wr = wave >> 1, wc = wave & 1, l16 = lane & 15, quad = lane >> 4;
    f32x4 acc[4][4];
    gemm_tile<true>(acc, [&](int r) {
        const int row = tmc * 128 + r, bg = row >> 9, c = row & 511;
        return src + ((size_t)((bg >> 1) * S_ + c * 16 + ks * 8)) * 128 + (bg & 1) * 64; }, 128, Bt, 512, smem, 2048);
#pragma unroll
    for (int mi = 0; mi < 4; ++mi)
#pragma unroll
        for (int ni = 0; ni < 4; ++ni) *(f32x4*)(hp + (size_t)(wr * 64 + mi * 16 + l16) * 128 + wc * 64 + ni * 16 + quad * 4) = acc[mi][ni];
}

DEVI void compress_finish(const Params& p, int l, int kv, int t32, float* sm) {
    unsigned char* ws = p.ws;
    const float* bias = (const float*)(ws + OFF_CBIAS) + (l * 2 + kv) * 8 * 128;
    const float* w2 = (kv ? p.cv_w2 : p.ck_w2) + (size_t)l * 128 * 64;
    const float* hp = (const float*)(ws + OFF_HIDP) + ((size_t)kv * 2048 + t32 * 32) * 128;
    float* hid = sm;
    float* w2s = sm + 32 * 129 + 3;
    w2s = sm + 4160;
    const int tid = TIDX;
#pragma unroll
    for (int i = 0; i < 8; ++i) *(f32x4*)(w2s + (i * 256 + tid) * 4) = *(const f32x4*)(w2 + (i * 256 + tid) * 4);
#pragma unroll
    for (int i = 0; i < 4; ++i) {
        const int e = (i * 256 + tid) * 4, row = e >> 7, col = e & 127;
        f32x4 v = *(const f32x4*)(bias + col);
#pragma unroll
        for (int sl = 1; sl < 8; ++sl) v += *(const f32x4*)(bias + sl * 128 + col);
#pragma unroll
        for (int ks = 0; ks < 4; ++ks) v += *(const f32x4*)(hp + (size_t)ks * 2 * 2048 * 128 + (size_t)row * 128 + col);
#pragma unroll
        for (int r = 0; r < 4; ++r) hid[row * 129 + col + r] = gelu_tanh(v[r]);
    }
    __syncthreads();
    {
        const int d = tid & 63, rq = tid >> 6;
        float o[8];
#pragma unroll
        for (int i = 0; i < 8; ++i) o[i] = 0.f;
#pragma unroll 4
        for (int n = 0; n < 128; ++n) {
            const float w = w2s[n * 64 + d];
#pragma unroll
            for (int i = 0; i < 8; ++i) o[i] += hid[(rq * 8 + i) * 129 + n] * w;
        }
        if (!kv) {
            bf16_t* kc = (bf16_t*)(ws + OFF_KC);
#pragma unroll
            for (int i = 0; i < 8; ++i) kc[(size_t)(t32 * 32 + rq * 8 + i) * 64 + d] = f2bf(o[i]);
        } else {
            bf16_t* vct = (bf16_t*)(ws + OFF_VCT);
#pragma unroll
            for (int i = 0; i < 8; ++i) {
                const int row = t32 * 32 + rq * 8 + i, bg = row >> 9, c = row & 511;
                vct[((size_t)(bg * 8 + (c >> 6)) * 64 + d) * 64 + (((c >> 2) & 3) * 16 + ((c >> 4) & 3) * 4 + (c & 3))] = f2bf(o[i]);
            }
        }
    }
    __syncthreads();
}

DEVI void phase_m2b(const Params& p, int l, unsigned char* smem) {
    for (int item = blockIdx.x; item < 128; item += gridDim.x) compress_finish(p, l, item >> 6, item & 63, (float*)smem);
}

DEVI void pool_item(const Params& p, int l, int tp, int gi, float* sm) {
    unsigned char* ws = p.ws;
    const float* upool = (const float*)(ws + OFF_UPOOL);
    bf16_t* cat = (bf16_t*)(ws + OFF_CAT);
    float* ul = sm;
    bf16_t* pb = (bf16_t*)(sm + 80 * 64);
    bf16_t* wt = pb + 64 * 72;
    const int tid = TIDX, lane = tid & 63, wave = wave_(), l16 = lane & 15, quad = lane >> 4;
    const int tok0 = tp * 64, s0 = tok0 & (S_ - 1);
    const int w = 2 << gi;
#pragma unroll
    for (int i = 0; i < 5; ++i) {
        const int idx = i * 256 + tid, row = idx >> 4, c4 = (idx & 15) * 4;
        const int sidx = s0 - 16 + row;
        const f32x4 v = sidx >= 0 ? *(const f32x4*)(upool + (size_t)(tok0 - 16 + row) * 256 + gi * 64 + c4) : (f32x4){0.f, 0.f, 0.f, 0.f};
        *(f32x4*)(ul + row * 64 + c4) = v;
    }
    {
        const float* wp = p.pool_w + ((size_t)(l * 4 + gi) * 64) * 64;
#pragma unroll
        for (int i = 0; i < 4; ++i) {
            const int idx = i * 256 + tid, c = idx >> 4, d4 = (idx & 15) * 4;
            const f32x4 v = *(const f32x4*)(wp + c * 64 + d4);
#pragma unroll
            for (int e = 0; e < 4; ++e) wt[(d4 + e) * 72 + c] = f2bf(v[e]);
        }
    }
    __syncthreads();
    {
        const int c = tid & 63, t0 = (tid >> 6) * 16;
        float sum = 0.f;
        for (int k = 0; k < w; ++k) sum += ul[(16 + t0 - k) * 64 + c];
#pragma unroll 4
        for (int i = 0; i < 16; ++i) {
            const int t = t0 + i;
            if (i > 0) sum += ul[(16 + t) * 64 + c] - ul[(16 + t - w) * 64 + c];
            const int sq = s0 + t;
            const float div = (float)(sq + 1 < w ? sq + 1 : w);
            pb[t * 72 + c] = f2bf(sum / div - ul[(16 + t) * 64 + c]);
        }
    }
    __syncthreads();
    {
        f32x4 acc[4];
#pragma unroll
        for (int nt = 0; nt < 4; ++nt) acc[nt] = (f32x4){0.f, 0.f, 0.f, 0.f};
#pragma unroll
        for (int ks = 0; ks < 2; ++ks) {
            const bf16x8 af = *(const bf16x8*)(pb + (wave * 16 + l16) * 72 + ks * 32 + quad * 8);
#pragma unroll
            for (int nt = 0; nt < 4; ++nt) {
                const bf16x8 bfr = *(const bf16x8*)(wt + (nt * 16 + l16) * 72 + ks * 32 + quad * 8);
                acc[nt] = mfma16(bfr, af, acc[nt]);
            }
        }
        const float* sc = p.pool_scale + l * 256 + gi * 64;
        bf16_t* dst = cat + (size_t)(tok0 + wave * 16 + l16) * 1024 + gi * 64;
#pragma unroll
        for (int nt = 0; nt < 4; ++nt) {
            const f32x4 s4 = *(const f32x4*)(sc + nt * 16 + quad * 4);
            const f32x4 o = acc[nt] * s4;
            u32x2 pk; pk.x = pk_bf16(o[0], o[1]); pk.y = pk_bf16(o[2], o[3]);
            *(u32x2*)(dst + nt * 16 + quad * 4) = pk;
        }
    }
    __syncthreads();
}

DEVI void s5_load_u(const float* ussm, int tok0, int G, float* us, int lane) {
    const float* up = ussm + (size_t)(tok0 + lane) * 256 + G * 16;
#pragma unroll
    for (int i = 0; i < 4; ++i) *(f32x4*)(us + lane * 16 + i * 4) = *(const f32x4*)(up + i * 4);
}

DEVI void s5_bfrags(const Params& p, int l, int G, bf16x8 (&bf)[8]) {
    const int lane = TIDX & 63, l16 = lane & 15, quad = lane >> 4;
    const float* S5B = (const float*)(p.ws + OFF_S5B);
#pragma unroll
    for (int nt = 0; nt < 8; ++nt) {
        const int n = nt * 16 + l16, pp = n & 63, im = n >> 6;
        const float* src = S5B + ((size_t)(l * 16 + G) * 64 + pp) * 32 + im * 16 + (quad & 1) * 8;
        const f32x4 a = *(const f32x4*)src, c = *(const f32x4*)(src + 4);
        u32x4 v = (u32x4){pk_bf16(a[0], a[1]), pk_bf16(a[2], a[3]), pk_bf16(c[0], c[1]), pk_bf16(c[2], c[3])};
        if (quad >= 2) v = (u32x4){0u, 0u, 0u, 0u};
        bf[nt] = __builtin_bit_cast(bf16x8, v);
    }
}
DEVI void s5_x_half(const float* us, bf16_t* XH, const bf16x8 (&bf)[8], int half) {
    const int lane = TIDX & 63, l16 = lane & 15, quad = lane >> 4;
#pragma unroll
    for (int mt = 0; mt < 2; ++mt) {
        const float* up = us + (half * 32 + mt * 16 + l16) * 16 + (quad & 1) * 8;
        const f32x4 a = *(const f32x4*)up, c = *(const f32x4*)(up + 4);
        u32x4 v = (u32x4){pk_bf16(a[0], a[1]), pk_bf16(a[2], a[3]), pk_bf16(c[0], c[1]), pk_bf16(c[2], c[3])};
        if (quad >= 2) v = (u32x4){0u, 0u, 0u, 0u};
        const bf16x8 af = __builtin_bit_cast(bf16x8, v);
#pragma unroll
        for (int nt = 0; nt < 8; ++nt) {
            const f32x4 acc = mfma16(af, bf[nt], (f32x4){0.f, 0.f, 0.f, 0.f});
#pragma unroll
            for (int r = 0; r < 4; ++r) XH[(mt * 16 + quad * 4 + r) * 136 + nt * 16 + l16] = f2bf(acc[r]);
        }
    }
}
DEVI float bf2f(bf16_t v) { return __uint_as_float((unsigned)v << 16); }

DEVI void s5_pass_a(const Params& p, int l, int witem, float* wl) {
    unsigned char* ws = p.ws;
    const int lane = TIDX & 63;
    const int G = witem & 15, k = (witem >> 4) & 127, b = witem >> 11;
    const int sidx = (l * 16 + G) * 64 + lane;
    const float4 a4 = ((const float4*)(ws + OFF_S5A))[sidx];
    bf16x8 bfr[8];
    s5_bfrags(p, l, G, bfr);
    float* us = wl;
    s5_load_u((const float*)(ws + OFF_USSM), b * S_ + k * 64, G, us, lane);
    __builtin_amdgcn_fence(__ATOMIC_RELEASE, "wavefront");
    __builtin_amdgcn_wave_barrier();
    __builtin_amdgcn_fence(__ATOMIC_ACQUIRE, "wavefront");
    bf16_t* XH = (bf16_t*)(wl + 1024);
    float hr = 0.f, hi = 0.f;
    for (int half = 0; half < 2; ++half) {
        s5_x_half(us, XH, bfr, half);
        __builtin_amdgcn_fence(__ATOMIC_RELEASE, "wavefront");
        __builtin_amdgcn_wave_barrier();
        __builtin_amdgcn_fence(__ATOMIC_ACQUIRE, "wavefront");
#pragma unroll 4
        for (int tt = 0; tt < 32; ++tt) {
            const float xr = bf2f(XH[tt * 136 + lane]), xi = bf2f(XH[tt * 136 + 64 + lane]);
            const float nr = a4.x * hr - a4.y * hi + xr, ni = a4.x * hi + a4.y * hr + xi;
            hr = nr; hi = ni;
        }
        __builtin_amdgcn_fence(__ATOMIC_RELEASE, "wavefront");
        __builtin_amdgcn_wave_barrier();
        __builtin_amdgcn_fence(__ATOMIC_ACQUIRE, "wavefront");
    }
    float2* E = (float2*)(ws + OFF_E);
    E[((size_t)(b * 128 + k) * 16 + G) * 64 + lane] = make_float2(hr, hi);
    __builtin_amdgcn_wave_barrier();
}

DEVI void phase_m2(const Params& p, int l, unsigned char* smem) {
    constexpr int NCMP = 128, NPOOL = 1024, NS5 = 1024;
    for (int item = blockIdx.x; item < NCMP + NPOOL + NS5; item += gridDim.x) {
        __syncthreads();
        if (item < NCMP) compress_partial(p, l, (item >> 4) & 1, item & 15, item >> 5, (bf16_t*)smem);
        else if (item < NCMP + NPOOL) { const int it = item - NCMP; pool_item(p, l, it >> 2, it & 3, (float*)smem); }
        else { const int it = item - NCMP - NPOOL; const int wv = wave_(); s5_pass_a(p, l, it * 4 + wv, (float*)(smem + wv * 16384)); }
    }
}

DEVI void s5_pass_b(const Params& p, int l, int witem, unsigned char* wlraw) {
    unsigned char* ws = p.ws;
    const int lane = TIDX & 63, l16 = lane & 15, quad = lane >> 4;
    const int G = witem & 15, k = (witem >> 4) & 127, b = witem >> 11;
    const int sidx = (l * 16 + G) * 64 + lane;
    const float4 a4 = ((const float4*)(ws + OFF_S5A))[sidx];
    bf16x8 bfr[8];
    s5_bfrags(p, l, G, bfr);
    float* us = (float*)wlraw;
    bf16_t* Hs = (bf16_t*)(wlraw + 4096);
    const int tok0 = b * S_ + k * 64;
    s5_load_u((const float*)(ws + OFF_USSM), tok0, G, us, lane);
    float hr = 0.f, hi = 0.f;
    {
        const float2* E = (const float2*)(ws + OFF_E) + ((size_t)(b * 128) * 16 + G) * 64 + lane;
#pragma unroll 8
        for (int kk = 0; kk < k; ++kk) {
            const float2 e = E[(size_t)kk * 16 * 64];
            const float nr = a4.z * hr - a4.w * hi + e.x, ni = a4.z * hi + a4.w * hr + e.y;
            hr = nr; hi = ni;
        }
    }
    bf16x8 cf[4];
    {
        const float* cre = p.c_re + ((size_t)(l * 16 + G) * 16 + l16) * 64 + quad * 8;
        const float* cim = p.c_im + ((size_t)(l * 16 + G) * 16 + l16) * 64 + quad * 8;
#pragma unroll
        for (int ks = 0; ks < 4; ++ks) {
            const float* sp = (ks < 2 ? cre : cim) + (ks & 1) * 32;
            const float sg = ks < 2 ? 1.f : -1.f;
            const float4 a = *(const float4*)sp, c = *(const float4*)(sp + 4);
            union { bf16x8 v; unsigned u[4]; } cv;
            cv.u[0] = pk_bf16(sg * a.x, sg * a.y); cv.u[1] = pk_bf16(sg * a.z, sg * a.w); cv.u[2] = pk_bf16(sg * c.x, sg * c.y); cv.u[3] = pk_bf16(sg * c.z, sg * c.w);
            cf[ks] = cv.v;
        }
    }
    const float dsk = p.ssm_d[(l * 16 + G) * 16 + l16];
    bf16_t* yg = (bf16_t*)(ws + OFF_YG);
    __builtin_amdgcn_fence(__ATOMIC_RELEASE, "wavefront");
    __builtin_amdgcn_wave_barrier();
    __builtin_amdgcn_fence(__ATOMIC_ACQUIRE, "wavefront");
    for (int half = 0; half < 2; ++half) {
        s5_x_half(us, Hs, bfr, half);
        __builtin_amdgcn_fence(__ATOMIC_RELEASE, "wavefront");
        __builtin_amdgcn_wave_barrier();
        __builtin_amdgcn_fence(__ATOMIC_ACQUIRE, "wavefront");
#pragma unroll 4
        for (int tt = 0; tt < 32; ++tt) {
            const float xr = bf2f(Hs[tt * 136 + lane]), xi = bf2f(Hs[tt * 136 + 64 + lane]);
            const float nr = a4.x * hr - a4.y * hi + xr, ni = a4.x * hi + a4.y * hr + xi;
            hr = nr; hi = ni;
            Hs[tt * 136 + lane] = f2bf(hr);
            Hs[tt * 136 + 64 + lane] = f2bf(hi);
        }
        __builtin_amdgcn_fence(__ATOMIC_RELEASE, "wavefront");
        __builtin_amdgcn_wave_barrier();
        __builtin_amdgcn_fence(__ATOMIC_ACQUIRE, "wavefront");
        f32x4 y[2];
#pragma unroll
        for (int mt = 0; mt < 2; ++mt) {
            y[mt] = (f32x4){0.f, 0.f, 0.f, 0.f};
#pragma unroll
            for (int ks = 0; ks < 4; ++ks) {
                const bf16x8 hf = *(const bf16x8*)(Hs + (mt * 16 + l16) * 136 + ks * 32 + quad * 8);
                y[mt] = mfma16(hf, cf[ks], y[mt]);
            }
        }
#pragma unroll
        for (int mt = 0; mt < 2; ++mt)
#pragma unroll
            for (int r = 0; r < 4; ++r) {
                const int t = half * 32 + mt * 16 + quad * 4 + r;
                const float yy = y[mt][r] + dsk * us[t * 16 + l16];
                yg[(size_t)(tok0 + t) * 256 + G * 16 + l16] = f2bf(gelu_tanh(yy));
            }
        __builtin_amdgcn_fence(__ATOMIC_RELEASE, "wavefront");
        __builtin_amdgcn_wave_barrier();
        __builtin_amdgcn_fence(__ATOMIC_ACQUIRE, "wavefront");
    }
}

constexpr int AT_ROW = 72;
constexpr int AT_TILE = 64 * AT_ROW;
DEVI void attn_item(const Params& p, int bg, int t0, unsigned char* smem) {
    unsigned char* ws = p.ws;
    const int tid = TIDX, lane = tid & 63, wave = wave_(), l16 = lane & 15, quad = lane >> 4;
    const int b = bg >> 1, g = bg & 1, r = l16 & 3;
    float* imp = (float*)(smem + 32768) + wave * 2096;
    float* impe = imp + 1024;
    unsigned* selw = (unsigned*)(imp + 2048);
    unsigned* anyw = selw + 32;
    int tq[2];
    tq[0] = t0 + wave * 8 + (l16 >> 2); tq[1] = tq[0] + 4;
    bf16x8 qf[2][2];
    float g_cmp[2], g_slc[2], g_win[2];
#pragma unroll
    for (int ct = 0; ct < 2; ++ct) {
        const size_t tok = (size_t)b * S_ + tq[ct];
        const bf16_t* qp = (const bf16_t*)(ws + OFF_Q) + tok * 512 + (g * 4 + r) * 64 + quad * 8;
        qf[ct][0] = *(const bf16x8*)qp; qf[ct][1] = *(const bf16x8*)(qp + 32);
        const float* gp = (const float*)(ws + OFF_GATES) + tok * 24 + (g * 4 + r) * 3;
        g_cmp[ct] = gp[0]; g_slc[ct] = gp[1]; g_win[ct] = gp[2];
    }
#pragma unroll
    for (int i = 0; i < 32; ++i) imp[i * 64 + lane] = 0.f;
    const bf16_t* kc = (const bf16_t*)(ws + OFF_KC) + (size_t)bg * 512 * 64;
    const bf16_t* vct = (const bf16_t*)(ws + OFF_VCT) + (size_t)bg * 8 * 4096;
    const bf16_t* ksl = (const bf16_t*)(ws + OFF_KSLC) + (size_t)bg * S_ * 64;
    const bf16_t* vsl = (const bf16_t*)(ws + OFF_VSLCT) + (size_t)bg * 128 * 4096;
    const bf16_t* kwn = (const bf16_t*)(ws + OFF_KWIN) + (size_t)bg * S_ * 64;
    const bf16_t* vwn = (const bf16_t*)(ws + OFF_VWINT) + (size_t)bg * 128 * 4096;
    const int tmax = t0 + 31;
    const int ncb = tmax >= 31 ? (((tmax - 31) >> 4) >> 6) + 1 : 0;
    const int cur = t0 >> 6;
    const int nsl = cur + 1;
    const int jlo = (t0 - 511 > 0 ? t0 - 511 : 0) >> 6;
    const int nwn = cur - jlo + 1;
    const int n1 = ncb, n2 = 2 * ncb, n3 = n2 + nsl, ntot = n3 + nwn;
    auto tile_ptrs = [&](int n, const bf16_t*& kp, const bf16_t*& vp) {
        if (n < n2) { const int c = n < n1 ? n : n - n1; kp = kc + (size_t)c * 4096; vp = vct + (size_t)c * 4096; }
        else if (n < n3) { const int j = n - n2; kp = ksl + (size_t)j * 4096; vp = vsl + (size_t)j * 4096; }
        else { const int j = jlo + (n - n3); kp = kwn + (size_t)j * 4096; vp = vwn + (size_t)j * 4096; }
    };
    unsigned gv0, gv1;
    {
        const int R0 = tid >> 3, R1 = 32 + (tid >> 3);
        gv0 = (unsigned)(R0 * 128 + (((tid & 7) ^ ((R0 >> 1) & 7)) * 16));
        gv1 = (unsigned)(R1 * 128 + (((tid & 7) ^ ((R1 >> 1) & 7)) * 16));
    }
    const unsigned alds0 = (unsigned)(size_t)((LAS unsigned char*)smem) + (unsigned)wave * 1024u;
    {
        const bf16_t *kp, *vp; tile_ptrs(0, kp, vp);
        glds_tile4(gv0, gv1, kp, vp, __builtin_amdgcn_readfirstlane(alds0));
    }
    const int rsw = l16 >> 1;
    f32x4 outacc[2][4], o[2][4];
    float m[2], lsum[2], invl[2];
    f32x4 lacc[2];
    const bf16x8 ones8 = __builtin_bit_cast(bf16x8, (u32x4){0x3f803f80u, 0x3f803f80u, 0x3f803f80u, 0x3f803f80u});
#pragma unroll
    for (int ct = 0; ct < 2; ++ct) {
        m[ct] = NEGBIG; lsum[ct] = 0.f; invl[ct] = 0.f; lacc[ct] = (f32x4){0.f, 0.f, 0.f, 0.f};
#pragma unroll
        for (int i = 0; i < 4; ++i) { outacc[ct][i] = (f32x4){0.f, 0.f, 0.f, 0.f}; o[ct][i] = (f32x4){0.f, 0.f, 0.f, 0.f}; }
    }
    const float NINF = -__builtin_inff();
    auto finalize = [&](const float (&gate)[2], bool normalise) {
#pragma unroll
        for (int ct = 0; ct < 2; ++ct) {
            float sc = gate[ct];
            if (normalise) { const float l = lacc[ct][0]; sc = l > 0.f ? gate[ct] / l : 0.f; }
#pragma unroll
            for (int i = 0; i < 4; ++i) { outacc[ct][i] += o[ct][i] * sc; o[ct][i] = (f32x4){0.f, 0.f, 0.f, 0.f}; }
            m[ct] = NEGBIG; lsum[ct] = 0.f; lacc[ct] = (f32x4){0.f, 0.f, 0.f, 0.f};
        }
    };
    auto trans = [&](const int n) {
        if (n == n1 && n1 > 0) {
#pragma unroll
            for (int ct = 0; ct < 2; ++ct) { float l = lsum[ct]; l += __shfl_xor(l, 16); l += __shfl_xor(l, 32); invl[ct] = l > 0.f ? 1.0f / l : 0.f; }
        }
        if (n == n2) {
            if (n1 > 0) finalize(g_cmp, false);
            else { m[0] = m[1] = NEGBIG; lsum[0] = lsum[1] = 0.f; }
            __builtin_amdgcn_fence(__ATOMIC_RELEASE, "wavefront");
            __builtin_amdgcn_wave_barrier();
            __builtin_amdgcn_fence(__ATOMIC_ACQUIRE, "wavefront");
            const int q8 = lane >> 3, jb = (lane & 7) * 16;
            const int tqq = t0 + wave * 8 + q8;
            float v[16];
#pragma unroll
            for (int i4 = 0; i4 < 4; ++i4) {
                const f32x4 x = *(const f32x4*)(imp + q8 * 128 + jb + i4 * 4);
                const int jm = jb + i4 * 4 - 1;
                const float ep = jm >= 0 ? impe[q8 * 128 + jm] : 0.f;
                const f32x4 ex = (f32x4){ep, impe[q8 * 128 + jm + 1], impe[q8 * 128 + jm + 2], impe[q8 * 128 + jm + 3]};
#pragma unroll
                for (int e = 0; e < 4; ++e) {
                    const int j = jb + i4 * 4 + e;
                    float iv = x[e] + ex[e];
                    const bool forced = (j == 0) || (j == cur) || (j == cur - 1);
                    if (forced) iv += 1e4f;
                    if (64 * j > tqq) iv = NEGBIG;
                    v[i4 * 4 + e] = iv;
                }
            }
            unsigned selbits = 0;
#pragma unroll 1
            for (int round = 0; round < 16; ++round) {
                float bv = v[0]; int bi = 0;
#pragma unroll
                for (int i = 1; i < 16; ++i) { const bool gt = v[i] > bv; bv = gt ? v[i] : bv; bi = gt ? i : bi; }
                int gi = jb + bi;
#define TOPK_STEP(CTRL) { \
                    const float ov = __int_as_float(__builtin_amdgcn_update_dpp(0, __float_as_int(bv), (CTRL), 0xf, 0xf, false)); \
                    const int oi = __builtin_amdgcn_update_dpp(0, gi, (CTRL), 0xf, 0xf, false); \
                    const bool take = (ov > bv) || (ov == bv && oi < gi); \
                    bv = take ? ov : bv; gi = take ? oi : gi; }
                TOPK_STEP(0xB1)
                TOPK_STEP(0x4E)
                TOPK_STEP(0x141)
#undef TOPK_STEP
                const bool mine = (gi >> 4) == (lane & 7);
                const int li = gi & 15;
                if (mine && bv > -1e29f) selbits |= 1u << li;
#pragma unroll
                for (int i = 0; i < 16; ++i) v[i] = (mine && i == li) ? NINF : v[i];
            }
            unsigned wv = selbits << ((lane & 1) * 16);
            wv |= __shfl_xor(wv, 1);
            if ((lane & 1) == 0) selw[q8 * 4 + ((lane & 7) >> 1)] = wv;
            __builtin_amdgcn_fence(__ATOMIC_RELEASE, "wavefront");
            __builtin_amdgcn_wave_barrier();
            __builtin_amdgcn_fence(__ATOMIC_ACQUIRE, "wavefront");
#pragma unroll
            for (int ct = 0; ct < 2; ++ct)
#pragma unroll
                for (int w = 0; w < 4; ++w) {
                    const unsigned a = selw[(ct * 4 + 0) * 4 + w] | selw[(ct * 4 + 1) * 4 + w] | selw[(ct * 4 + 2) * 4 + w] | selw[(ct * 4 + 3) * 4 + w];
                    if (lane == 0) anyw[ct * 4 + w] = a;
                }
            __builtin_amdgcn_fence(__ATOMIC_RELEASE, "wavefront");
            __builtin_amdgcn_wave_barrier();
            __builtin_amdgcn_fence(__ATOMIC_ACQUIRE, "wavefront");
        }
        if (n == n3) finalize(g_slc, true);
    };
    auto body = [&](auto kc, const int n) {
        constexpr int KIND = decltype(kc)::value;
        asm volatile("s_waitcnt vmcnt(0)\n\ts_barrier" ::: "memory");
        if (n + 1 < ntot) {
            const bf16_t *kp, *vp; tile_ptrs(n + 1, kp, vp);
            glds_tile4(gv0, gv1, kp, vp, __builtin_amdgcn_readfirstlane(alds0 + ((n + 1) & 1) * 16384));
        }
        const unsigned char* cK = smem + (n & 1) * 16384;
        const unsigned char* cV = cK + 8192;
        constexpr bool is_p1 = KIND == 0, is_p2 = KIND == 1, is_slc = KIND == 2 || KIND == 4;
        const int jt = is_slc ? n - n2 : jlo + (n - n3);
        const bool elem = KIND == 3 || (is_slc && jt == cur);
        const int wlim = is_slc ? 0x40000000 : 512;
        const int c0 = (is_p1 ? n : n - n1) * 64;
        bool any_act = true;
        if (is_slc && !elem) {
            const unsigned aw = __builtin_amdgcn_readfirstlane(anyw[jt >> 5] | anyw[4 + (jt >> 5)]);
            any_act = (aw >> (jt & 31)) & 1u;
        }
        if (any_act) {
            f32x4 s[2][4];
            {
                bf16x8 k0[4], k1[4];
#pragma unroll
                for (int mt = 0; mt < 4; ++mt) {
                    k0[mt] = *(const bf16x8*)(cK + (mt * 16 + l16) * 128 + ((quad ^ rsw) * 16));
                    k1[mt] = *(const bf16x8*)(cK + (mt * 16 + l16) * 128 + (((4 + quad) ^ rsw) * 16));
                }
#pragma unroll
                for (int mt = 0; mt < 4; ++mt)
#pragma unroll
                    for (int ct = 0; ct < 2; ++ct) s[ct][mt] = mfma16(k0[mt], qf[ct][0], (f32x4){0.f, 0.f, 0.f, 0.f});
#pragma unroll
                for (int mt = 0; mt < 4; ++mt)
#pragma unroll
                    for (int ct = 0; ct < 2; ++ct) s[ct][mt] = mfma16(k1[mt], qf[ct][1], s[ct][mt]);
            }
            if (is_p1) {
                float bm[2];
#pragma unroll
                for (int ct = 0; ct < 2; ++ct) {
                    bm[ct] = NINF;
#pragma unroll
                    for (int mt = 0; mt < 4; ++mt)
#pragma unroll
                        for (int rr = 0; rr < 4; ++rr) {
                            const int c = c0 + mt * 16 + quad * 4 + rr;
                            const float x = (16 * c + 31 <= tq[ct]) ? s[ct][mt][rr] * LOG2E : NINF;
                            s[ct][mt][rr] = x; bm[ct] = fmaxf(bm[ct], x);
                        }
                }
#pragma unroll
                for (int ct = 0; ct < 2; ++ct) bm[ct] = fmaxf(bm[ct], __shfl_xor(bm[ct], 16));
#pragma unroll
                for (int ct = 0; ct < 2; ++ct) bm[ct] = fmaxf(bm[ct], __shfl_xor(bm[ct], 32));
#pragma unroll
                for (int ct = 0; ct < 2; ++ct) {
                    const float mn = fmaxf(m[ct], bm[ct]);
                    float ls = 0.f;
#pragma unroll
                    for (int mt = 0; mt < 4; ++mt)
#pragma unroll
                        for (int rr = 0; rr < 4; ++rr) ls += fast_exp2(s[ct][mt][rr] - mn);
                    lsum[ct] = lsum[ct] * fast_exp2(m[ct] - mn) + ls;
                    m[ct] = mn;
                }
            } else {
                if (is_p2) {
#pragma unroll
                    for (int ct = 0; ct < 2; ++ct) {
                        const int q8 = ct * 4 + (l16 >> 2);
#pragma unroll
                        for (int mt = 0; mt < 4; ++mt) {
#pragma unroll
                            for (int rr = 0; rr < 4; ++rr) {
                                const int c = c0 + mt * 16 + quad * 4 + rr;
                                s[ct][mt][rr] = (16 * c + 31 <= tq[ct]) ? fast_exp2(s[ct][mt][rr] * LOG2E - m[ct]) * invl[ct] : 0.f;
                            }
                            float gs = (s[ct][mt][0] + s[ct][mt][1]) + (s[ct][mt][2] + s[ct][mt][3]);
                            float es = s[ct][mt][3];
                            gs += __int_as_float(__builtin_amdgcn_update_dpp(0, __float_as_int(gs), 0xB1, 0xf, 0xf, false));
                            gs += __int_as_float(__builtin_amdgcn_update_dpp(0, __float_as_int(gs), 0x4E, 0xf, 0xf, false));
                            es += __int_as_float(__builtin_amdgcn_update_dpp(0, __float_as_int(es), 0xB1, 0xf, 0xf, false));
                            es += __int_as_float(__builtin_amdgcn_update_dpp(0, __float_as_int(es), 0x4E, 0xf, 0xf, false));
                            if (r == 0) {
                                const int j = (c0 >> 2) + mt * 4 + quad;
                                imp[q8 * 128 + j] = gs;
                                impe[q8 * 128 + j] = es;
                            }
                        }
                    }
                } else {
                    float bias[2], mr[2], mn[2], ls[2];
#pragma unroll
                    for (int ct = 0; ct < 2; ++ct) {
                        bias[ct] = 0.f; ls[ct] = 0.f; (void)ls[ct];
                        if (is_slc) {
                            const int q8 = ct * 4 + (l16 >> 2);
                            const unsigned w = selw[q8 * 4 + (jt >> 5)];
                            bias[ct] = ((w >> (jt & 31)) & 1u) ? 0.f : NINF;
                        }
                    }
                    if (elem) {
#pragma unroll
                        for (int ct = 0; ct < 2; ++ct) {
                            mr[ct] = NINF;
#pragma unroll
                            for (int mt = 0; mt < 4; ++mt)
#pragma unroll
                                for (int rr = 0; rr < 4; ++rr) {
                                    float x = __builtin_fmaf(s[ct][mt][rr], LOG2E, bias[ct]);
                                    const int dist = tq[ct] - (jt * 64 + mt * 16 + quad * 4 + rr);
                                    x = (dist >= 0 && dist < wlim) ? x : NINF;
                                    s[ct][mt][rr] = x; mr[ct] = fmaxf(mr[ct], x);
                                }
                        }
#pragma unroll
                        for (int ct = 0; ct < 2; ++ct) mr[ct] = fmaxf(mr[ct], __shfl_xor(mr[ct], 16));
#pragma unroll
                        for (int ct = 0; ct < 2; ++ct) mr[ct] = fmaxf(mr[ct], __shfl_xor(mr[ct], 32));
                        bool need = false;
#pragma unroll
                        for (int ct = 0; ct < 2; ++ct) need = need || (fmaxf(m[ct], mr[ct]) - m[ct] > 8.0f);
                        const bool resc = __builtin_amdgcn_ballot_w64(need) != 0;
#pragma unroll
                        for (int ct = 0; ct < 2; ++ct) {
                            mn[ct] = resc ? fmaxf(m[ct], mr[ct]) : m[ct];
#pragma unroll
                            for (int mt = 0; mt < 4; ++mt)
#pragma unroll
                                for (int rr = 0; rr < 4; ++rr) { s[ct][mt][rr] = fast_exp2(s[ct][mt][rr] - mn[ct]); }
                        }
                    } else {
#pragma unroll
                        for (int ct = 0; ct < 2; ++ct) {
                            mr[ct] = fmaxf(fmaxf(s[ct][0][0], s[ct][0][1]), fmaxf(s[ct][0][2], s[ct][0][3]));
#pragma unroll
                            for (int mt = 1; mt < 4; ++mt) mr[ct] = fmaxf(mr[ct], fmaxf(fmaxf(s[ct][mt][0], s[ct][mt][1]), fmaxf(s[ct][mt][2], s[ct][mt][3])));
                        }
#pragma unroll
                        for (int ct = 0; ct < 2; ++ct) mr[ct] = fmaxf(mr[ct], __shfl_xor(mr[ct], 16));
#pragma unroll
                        for (int ct = 0; ct < 2; ++ct) mr[ct] = fmaxf(mr[ct], __shfl_xor(mr[ct], 32));
                        float cand[2];
                        bool need = false;
#pragma unroll
                        for (int ct = 0; ct < 2; ++ct) {
                            cand[ct] = fmaxf(m[ct], __builtin_fmaf(mr[ct], LOG2E, bias[ct]));
                            need = need || (cand[ct] - m[ct] > 8.0f);
                        }
                        const bool resc = __builtin_amdgcn_ballot_w64(need) != 0;
#pragma unroll
                        for (int ct = 0; ct < 2; ++ct) {
                            mn[ct] = resc ? cand[ct] : m[ct];
                            const float nb = bias[ct] - mn[ct];
#pragma unroll
                            for (int mt = 0; mt < 4; ++mt)
#pragma unroll
                                for (int rr = 0; rr < 4; ++rr) { s[ct][mt][rr] = fast_exp2(__builtin_fmaf(s[ct][mt][rr], LOG2E, nb)); }
                        }
                    }
                    float al[2];
#pragma unroll
                    for (int ct = 0; ct < 2; ++ct) {
                        al[ct] = fast_exp2(m[ct] - mn[ct]);
                        m[ct] = mn[ct];
                    }
                    if (__builtin_amdgcn_ballot_w64(al[0] != 1.0f || al[1] != 1.0f)) {
#pragma unroll
                        for (int ct = 0; ct < 2; ++ct)
#pragma unroll
                            for (int i = 0; i < 4; ++i) o[ct][i] *= al[ct];
#pragma unroll
                        for (int ct = 0; ct < 2; ++ct) lacc[ct] *= al[ct];
                    }
                }
#pragma unroll
                for (int kk = 0; kk < 2; ++kk) {
                    u32x4 pb[2];
#pragma unroll
                    for (int ct = 0; ct < 2; ++ct)
                        pb[ct] = (u32x4){pk_bf16(s[ct][2 * kk][0], s[ct][2 * kk][1]), pk_bf16(s[ct][2 * kk][2], s[ct][2 * kk][3]),
                                         pk_bf16(s[ct][2 * kk + 1][0], s[ct][2 * kk + 1][1]), pk_bf16(s[ct][2 * kk + 1][2], s[ct][2 * kk + 1][3])};
                    lacc[0] = mfma16(ones8, __builtin_bit_cast(bf16x8, pb[0]), lacc[0]);
                    lacc[1] = mfma16(ones8, __builtin_bit_cast(bf16x8, pb[1]), lacc[1]);
#pragma unroll
                    for (int dt = 0; dt < 4; ++dt) {
                        const bf16x8 va = *(const bf16x8*)(cV + (dt * 16 + l16) * 128 + (((quad * 2 + kk) ^ rsw) * 16));
                        o[0][dt] = mfma16(va, __builtin_bit_cast(bf16x8, pb[0]), o[0][dt]);
                        o[1][dt] = mfma16(va, __builtin_bit_cast(bf16x8, pb[1]), o[1][dt]);
                    }
                }
            }
        }
    };
    {
        int n = 0;
#pragma unroll 1
        for (; n < n1; ++n) body(std::integral_constant<int, 0>{}, n);
        trans(n1);
#pragma unroll 1
        for (; n < n2; ++n) body(std::integral_constant<int, 1>{}, n);
        if (n2 != n1) trans(n2);
#pragma unroll 1
        for (; n < n3; ++n) body(std::integral_constant<int, 2>{}, n);
        trans(n3);
#pragma unroll 1
        for (; n < ntot; ++n) body(std::integral_constant<int, 3>{}, n);
    }
    finalize(g_win, true);
#pragma unroll
    for (int ct = 0; ct < 2; ++ct) {
        bf16_t* cat = (bf16_t*)(ws + OFF_CAT) + ((size_t)b * S_ + tq[ct]) * 1024 + 256 + (g * 4 + r) * 64 + quad * 4;
#pragma unroll
        for (int dt = 0; dt < 4; ++dt) {
            u32x2 pk; pk.x = pk_bf16(outacc[ct][dt][0], outacc[ct][dt][1]); pk.y = pk_bf16(outacc[ct][dt][2], outacc[ct][dt][3]);
            *(u32x2*)(cat + dt * 16) = pk;
        }
    }
    __syncthreads();
}

DEVI void phase_m3(const Params& p, int l, unsigned char* smem) {
    const int G = gridDim.x, bid = blockIdx.x;
    if ((G & 7) == 0) {
        const int x = bid & 7, bg = x & 3, nb = G >> 3, lb = (bid >> 3) + nb * (x >> 2);
        for (int pi = lb; pi < 128; pi += 2 * nb) {
            attn_item(p, bg, (255 - pi) * 32, smem);
            attn_item(p, bg, pi * 32, smem);
        }
    } else {
        for (int item = bid; item < 1024; item += G) attn_item(p, item & 3, (item >> 2) * 32, smem);
    }
    for (int i = bid; i < 1024; i += G) {
        const int wv = wave_();
        int wi = i * 4 + wv;
        if (i >= 512) { const int k = (wi >> 4) & 127; wi = (wi & ~(127 << 4)) | ((127 - k) << 4); }
        __syncthreads();
        s5_pass_b(p, l, wi, smem + wv * 16384);
    }
}

DEVI void phase_glu(const Params& p, int l, bf16_t* smem) {
    unsigned char* ws = p.ws;
    const bf16_t* A = (const bf16_t*)(ws + OFF_YG);
    const bf16_t* Bt = (const bf16_t*)(ws + OFF_W + (size_t)l * SZ_LAYER + OL_GLUT);
    bf16_t* cat = (bf16_t*)(ws + OFF_CAT);
    const float* gb = p.glu_b + l * 256;
    const int lane = TIDX & 63, wave = wave_(), wr = wave >> 1, wc = wave & 1, l16 = lane & 15, quad = lane >> 4;
    for (int it = 0;; ++it) {
        int tm, tn; if (!tile_map(it, 2, tm, tn)) break;
        f32x4 acc[4][4];
        const bf16_t* Ab = A + (size_t)tm * 128 * 256;
        gemm_tile<true>(acc, [&](int r) { return Ab + (size_t)r * 256; }, 64, Bt + (size_t)tn * 128 * 256, 256, smem);
#pragma unroll
        for (int mi = 0; mi < 4; ++mi)
#pragma unroll
            for (int ni = 0; ni < 4; ++ni) {
                const int row = tm * 128 + wr * 64 + mi * 16 + l16, col = tn * 128 + wc * 64 + ni * 16 + quad * 4;
                const u32x2 yb = *(const u32x2*)(A + (size_t)row * 256 + col);
                const f32x4 gb4 = *(const f32x4*)(gb + col);
                float o[4];
                o[0] = __uint_as_float(yb.x << 16) * sigmoidf_(acc[mi][ni][0] + gb4[0]);
                o[1] = __uint_as_float(yb.x & 0xffff0000u) * sigmoidf_(acc[mi][ni][1] + gb4[1]);
                o[2] = __uint_as_float(yb.y << 16) * sigmoidf_(acc[mi][ni][2] + gb4[2]);
                o[3] = __uint_as_float(yb.y & 0xffff0000u) * sigmoidf_(acc[mi][ni][3] + gb4[3]);
                u32x2 pk; pk.x = pk_bf16(o[0], o[1]); pk.y = pk_bf16(o[2], o[3]);
                *(u32x2*)(cat + (size_t)row * 1024 + 768 + col) = pk;
            }
    }
}


#define XB_TMO      128
#define XB_XCNT(j)  (256  + 64 * (j))
#define XB_XSUB(j)  (1280 + 64 * (j))
#define XB_XGEN(j)  (2304 + 64 * (j))
#define XB_TOP      3328
#define XB_TOPGEN   3392
#define XCD_BAR_WORDS 3456
#define XB_SPIN_CAP (1u << 20)
DEVI unsigned xb_ld(unsigned* p) { return __hip_atomic_load(p, __ATOMIC_RELAXED, __HIP_MEMORY_SCOPE_AGENT); }
DEVI unsigned xb_add(unsigned* p, unsigned v) { return __hip_atomic_fetch_add(p, v, __ATOMIC_RELAXED, __HIP_MEMORY_SCOPE_AGENT); }
DEVI unsigned xb_xcc_id() { return (unsigned)__builtin_amdgcn_s_getreg((3 << 11) | 20) & 0xFu; }
#define XB_SPIN(cond, bar) do { unsigned _sp = 0; while (cond) { __builtin_amdgcn_s_sleep(1); \
    if ((++_sp & 255u) == 0u) { if (xb_ld(&(bar)[XB_TMO])) break; if (_sp > XB_SPIN_CAP) { atomicAdd(&(bar)[XB_TMO], 1u); break; } } } } while (0)
struct XcdBarrier { unsigned* bar; unsigned x; volatile LAS unsigned* st; };
DEVI XcdBarrier xcd_barrier_post(unsigned* bar, volatile LAS unsigned* st) {
    XcdBarrier b; b.bar = bar; b.x = xb_xcc_id(); b.st = st;
    if (threadIdx.x == 0) (void)xb_add(&bar[XB_XCNT(b.x)], 1u);
    return b;
}
DEVI void xcd_barrier_complete(unsigned* bar, unsigned x, unsigned& nloc, unsigned& nx) {
    const unsigned G = gridDim.x * gridDim.y * gridDim.z;
    unsigned sum, cnt, mine, sp = 0u;
    for (;;) {
        sum = 0u; cnt = 0u; mine = 0u;
#pragma unroll
        for (unsigned j = 0; j < 16; ++j) { const unsigned c = xb_ld(&bar[XB_XCNT(j)]); sum += c; cnt += (c > 0u) ? 1u : 0u; mine = (j == x) ? c : mine; }
        if (sum == G) break;
        __builtin_amdgcn_s_sleep(1);
        if ((++sp & 255u) == 0u) { if (xb_ld(&bar[XB_TMO])) break; if (sp > XB_SPIN_CAP) { atomicAdd(&bar[XB_TMO], 1u); break; } }
    }
    nloc = mine > 0u ? mine : 1u; nx = cnt > 0u ? cnt : 1u;
}
DEVI void xcd_barrier(const XcdBarrier& b) {
    asm volatile("s_waitcnt vmcnt(0)" ::: "memory");
    __syncthreads();
    if (threadIdx.x == 0) {
        unsigned* bar = b.bar;
        __builtin_amdgcn_s_waitcnt(0);
        unsigned nloc = b.st[0], nx = b.st[1];
        if (nloc == 0u) { xcd_barrier_complete(bar, b.x, nloc, nx); b.st[0] = nloc; b.st[1] = nx; }
        const unsigned old = xb_add(&bar[XB_XSUB(b.x)], 1u);
        const unsigned gen = old / nloc;
        if (old + 1u == (gen + 1u) * nloc) {
            __builtin_amdgcn_fence(__ATOMIC_RELEASE, "agent");
            asm volatile("s_waitcnt vmcnt(0)" ::: "memory");
            const unsigned og = xb_add(&bar[XB_TOP], 1u);
            const unsigned tg = og / nx;
            if (og + 1u == (tg + 1u) * nx) xb_add(&bar[XB_TOPGEN], 1u);
            else XB_SPIN(xb_ld(&bar[XB_TOPGEN]) == tg, bar);
            __builtin_amdgcn_fence(__ATOMIC_ACQUIRE, "agent");
            xb_add(&bar[XB_XGEN(b.x)], 1u);
            asm volatile("s_waitcnt vmcnt(0)" ::: "memory");
        } else {
            XB_SPIN(xb_ld(&bar[XB_XGEN(b.x)]) == gen, bar);
            __builtin_amdgcn_fence(__ATOMIC_ACQUIRE, "agent");
            asm volatile("s_waitcnt vmcnt(0)" ::: "memory");
        }
    }
    __syncthreads();
}

constexpr int NSUB = 13;
constexpr int NPHASE = 1 + 4 * NSUB;

#ifndef ONLY_SUB
#define ONLY_SUB -1
#endif
#define EN(n) (ONLY_SUB < 0 || ONLY_SUB == (n))
DEVI void run_phase(const Params& p0, int ph, unsigned char* smem) {
    Params p = p0;
    { size_t z = 0; asm volatile("" : "+s"(z)); p.ws = p0.ws + z; }
    if (ph == 0) { if (EN(100)) phase_prologue(p, smem); return; }
    const int l = (ph - 1) / NSUB, sub = (ph - 1) % NSUB;
    unsigned char* ws = p.ws;
    const bf16_t* lw = (const bf16_t*)(ws + OFF_W + (size_t)l * SZ_LAYER);
    switch (sub) {
        case 0: case 10: if (EN(0)) phase_ffn_in(p, l, sub == 10, (bf16_t*)smem); break;
        case 1: case 11: if (EN(1)) {
            const float* res = (l == 0 && sub == 1) ? p.x : nullptr;
            const int lnidx = sub == 1 ? (l > 0 ? (l - 1) * 3 + 2 : 0) : l * 3 + 1;
            const bf16_t* Bt = (const bf16_t*)((const unsigned char*)lw + (sub == 11 ? OL_W2T1 : OL_W2T0));
            phase_gemm_res(p, (const bf16_t*)(ws + OFF_ACT), DFF, Bt, res, lnidx, 0.5f, (bf16_t*)smem);
        } break;
        case 2: case 9: case 12: if (EN(2)) phase_ln(p, l, sub == 2 ? 0 : (sub == 9 ? 1 : 2), l == 3 && sub == 12); break;
        case 3: if (EN(3)) phase_inproj(p, l, (bf16_t*)smem); break;
        case 4: if (EN(4)) phase_m2(p, l, smem); break;
        case 5: if (EN(5)) phase_m2b(p, l, smem); break;
        case 6: if (EN(6)) phase_m3(p, l, smem); break;
        case 7: if (EN(7)) phase_glu(p, l, (bf16_t*)smem); break;
        case 8: if (EN(8)) phase_gemm_res(p, (const bf16_t*)(ws + OFF_CAT), 1024, (const bf16_t*)((const unsigned char*)lw + OL_WOUTT), nullptr, l * 3 + 0, 1.0f, (bf16_t*)smem); break;
    }
}

__global__ void __launch_bounds__(256, 2) mega(Params p, int ph_lo, int ph_hi) {
    __shared__ __attribute__((aligned(16))) unsigned char smem[SMEM_BYTES];
    __shared__ u32x4 xbw;
    if (threadIdx.x == 0) xbw = (u32x4){0u, 0u, 0u, 0u};
    __syncthreads();
    XcdBarrier xb = xcd_barrier_post((unsigned*)(p.ws + OFF_BAR), (volatile LAS unsigned*)&xbw);
    for (int ph = ph_lo; ph < ph_hi; ++ph) {
#ifdef PROBE_DUP
        {
            const int sub = ph == 0 ? 100 : (ph - 1) % NSUB;
            if (sub == PROBE_DUP || (PROBE_DUP == 0 && sub == 10)) { run_phase(p, ph, smem); xcd_barrier(xb); }
        }
#endif
        run_phase(p, ph, smem);
        if (ph + 1 < ph_hi) {
            if (ph_hi < 0) cg::this_grid().sync();
            xcd_barrier(xb);
        }
    }
}

extern "C" void kernel_launch(void* const* d_in, const int* in_sizes, int n_in, void* d_out, int out_size, void* d_ws, size_t ws_size,
                              hipStream_t stream) {
    Params p{};
    const float** pp = (const float**)&p;
    for (int i = 0; i < 27; ++i) pp[i] = (const float*)d_in[i];
    p.out = (float*)d_out;
    p.ws = (unsigned char*)d_ws;
    if (ws_size < WS_TOTAL) fprintf(stderr, "workspace too small: %zu < %zu\n", ws_size, (size_t)WS_TOTAL);
    static int grid_blocks = 0;
    if (!grid_blocks) {
        int dev = 0, cus = 0, per_cu = 0;
        hipGetDevice(&dev);
        hipDeviceGetAttribute(&cus, hipDeviceAttributeMultiprocessorCount, dev);
        hipOccupancyMaxActiveBlocksPerMultiprocessor(&per_cu, mega, 256, 0);
        if (per_cu < 1) per_cu = 1;
        if (per_cu > 2) per_cu = 2;
        grid_blocks = cus * per_cu;
    }
#if MULTI
    for (int ph = 0; ph < NPHASE; ++ph) {
        hipLaunchKernelGGL(mega, dim3(grid_blocks), dim3(256), 0, stream, p, ph, ph + 1);
    }
#else
    (void)hipMemsetAsync((unsigned char*)d_ws + OFF_BAR, 0, BAR_BYTES, stream);
    int lo = 0, hi = NPHASE;
    void* args[] = {&p, &lo, &hi};
    hipError_t e = hipLaunchCooperativeKernel((void*)mega, dim3(grid_blocks), dim3(256), args, 0, stream);
    if (e != hipSuccess) fprintf(stderr, "cooperative launch failed: %s (grid %d)\n", hipGetErrorString(e), grid_blocks);
#endif
}
```

```cpp
#include <hip/hip_runtime.h>
#include <hip/hip_cooperative_groups.h>
#include <stdint.h>
#include <type_traits>
#include <cstdio>
namespace cg = cooperative_groups;

#ifndef MULTI
#define MULTI 0
#endif

#define DEVI __device__ __forceinline__
#define TIDX tid_()
#define LAS __attribute__((address_space(3)))
typedef unsigned short bf16_t;
typedef short bf16x8 __attribute__((ext_vector_type(8)));
typedef short bf16x4 __attribute__((ext_vector_type(4)));
typedef float f32x4 __attribute__((ext_vector_type(4)));
typedef float f32x2v __attribute__((ext_vector_type(2)));
typedef unsigned u32x4 __attribute__((ext_vector_type(4)));
typedef unsigned u32x2 __attribute__((ext_vector_type(2)));

constexpr int T_ = 16384, S_ = 8192, D_ = 1024, DFF = 2816, NIN = 1920, NINSRC = 1816;
constexpr float ALPHA = 1.6817928305074290f;
constexpr float LOG2E = 1.4426950408889634f;
constexpr float NEGBIG = -1e30f;

constexpr size_t SZ_W1T = (size_t)5632 * 1024 * 2, SZ_W2T = (size_t)1024 * 2816 * 2, SZ_WINT = (size_t)NIN * 1024 * 2,
                 SZ_WOUTT = (size_t)1024 * 1024 * 2, SZ_CW1T = (size_t)128 * 2048 * 2, SZ_GLUT = (size_t)256 * 256 * 2;
constexpr size_t OL_W1T0 = 0, OL_W1T1 = OL_W1T0 + SZ_W1T, OL_W2T0 = OL_W1T1 + SZ_W1T, OL_W2T1 = OL_W2T0 + SZ_W2T,
                 OL_WINT = OL_W2T1 + SZ_W2T, OL_WOUTT = OL_WINT + SZ_WINT, OL_CW1K = OL_WOUTT + SZ_WOUTT, OL_CW1V = OL_CW1K + SZ_CW1T,
                 OL_GLUT = OL_CW1V + SZ_CW1T, SZ_LAYER = OL_GLUT + SZ_GLUT;
constexpr size_t OFF_W = 0;
constexpr size_t OFF_COS = OFF_W + 4 * SZ_LAYER, OFF_SIN = OFF_COS + (size_t)S_ * 32 * 4, OFF_CBIAS = OFF_SIN + (size_t)S_ * 32 * 4,
                 OFF_S5A = OFF_CBIAS + 32768, OFF_S5B = OFF_S5A + (size_t)4 * 16 * 64 * 16, OFF_H = OFF_S5B + (size_t)4 * 16 * 64 * 32 * 4,
                 OFF_HB = OFF_H + (size_t)T_ * D_ * 4, OFF_U = OFF_HB + (size_t)T_ * D_ * 2;
constexpr size_t OFF_ACT = OFF_U;
constexpr size_t OFF_Q = OFF_U, OFF_KCMP = OFF_Q + (size_t)T_ * 512 * 2, OFF_VCMP = OFF_KCMP + (size_t)T_ * 128 * 2,
                 OFF_KSLC = OFF_VCMP + (size_t)T_ * 128 * 2, OFF_VSLCT = OFF_KSLC + (size_t)T_ * 128 * 2, OFF_KWIN = OFF_VSLCT + (size_t)T_ * 128 * 2,
                 OFF_VWINT = OFF_KWIN + (size_t)T_ * 128 * 2, OFF_KC = OFF_VWINT + (size_t)T_ * 128 * 2, OFF_VCT = OFF_KC + (size_t)4 * 512 * 64 * 2,
                 OFF_GATES = OFF_VCT + (size_t)4 * 512 * 64 * 2, OFF_UPOOL = OFF_GATES + (size_t)T_ * 24 * 4, OFF_USSM = OFF_UPOOL + (size_t)T_ * 256 * 4,
                 OFF_E = OFF_USSM + (size_t)T_ * 256 * 4, OFF_YG = OFF_E + (size_t)2 * 128 * 16 * 64 * 8, OFF_HIDP = OFF_YG + (size_t)T_ * 256 * 2,
                 OFF_MIXEND = OFF_HIDP + (size_t)8 * 2048 * 128 * 4;
constexpr size_t OFF_ACTEND = OFF_ACT + (size_t)T_ * DFF * 2;
constexpr size_t WS_NEED = (OFF_MIXEND > OFF_ACTEND ? OFF_MIXEND : OFF_ACTEND);
constexpr size_t OFF_CAT = OFF_HB;
constexpr size_t OFF_BAR = WS_NEED, BAR_BYTES = 16384, OFF_STATS = OFF_BAR + BAR_BYTES, WS_TOTAL = OFF_STATS + (size_t)T_ * 8;

struct Params {
    const float *x, *ln_g, *ln_b, *ffn1_in, *ffn1_out, *ffn2_in, *ffn2_out, *w_in, *w_out, *pool_w, *pool_scale, *pe_k, *pe_v,
        *ck_w1, *ck_w2, *cv_w1, *cv_w2, *lam_re, *lam_im, *log_dt, *b_re, *b_im, *c_re, *c_im, *ssm_d, *glu_w, *glu_b;
    float* out;
    unsigned char* ws;
};

DEVI int tid_() { int t = threadIdx.x; asm volatile("" : "+v"(t)); return t; }
DEVI int wave_() { return __builtin_amdgcn_readfirstlane(tid_() >> 6); }
typedef __bf16 bf16x2n __attribute__((ext_vector_type(2)));
DEVI unsigned pk_bf16(float lo, float hi) { const bf16x2n r = __builtin_convertvector((f32x2v){lo, hi}, bf16x2n); return __builtin_bit_cast(unsigned, r); }
DEVI bf16_t f2bf(float f) { return (bf16_t)(pk_bf16(f, 0.f) & 0xffffu); }
DEVI float fast_exp2(float x) { return __builtin_amdgcn_exp2f(x); }
DEVI float rcp_(float x) { return __builtin_amdgcn_rcpf(x); }
DEVI float sigmoidf_(float x) { return rcp_(1.0f + fast_exp2(-x * LOG2E)); }
DEVI float gelu_tanh(float x) {
    const float z = 0.7978845608028654f * (x + 0.044715f * x * x * x);
    const float th = 1.0f - 2.0f * rcp_(1.0f + fast_exp2(z * (2.0f * LOG2E)));
    return 0.5f * x * (1.0f + th);
}
DEVI f32x4 mfma16(bf16x8 a, bf16x8 b, f32x4 c) { return __builtin_amdgcn_mfma_f32_16x16x32_bf16(a, b, c, 0, 0, 0); }

constexpr int LDS_ROW = 72;
constexpr int TILE_ELEMS = 128 * LDS_ROW;
constexpr int SMEM_BYTES = 4 * TILE_ELEMS * 2;

DEVI void glds16(const void* gsrc, unsigned lds_dst) {
    unsigned keep;
    asm volatile("s_mov_b32 %0, m0\n\ts_mov_b32 m0, %2\n\ts_nop 0\n\tglobal_load_lds_dwordx4 %1, off\n\ts_mov_b32 m0, %0"
                 : "=&s"(keep) : "v"(gsrc), "s"(lds_dst) : "memory");
}
DEVI void glds_tile8(const unsigned (&va)[4], const unsigned (&vb)[4], const void* sa, const void* sb, unsigned lds) {
    unsigned keep;
    asm volatile(
        "s_mov_b32 %[keep], m0\n\t"
        "s_mov_b32 m0, %[l]\n\ts_nop 0\n\tglobal_load_lds_dwordx4 %[a0], %[sa]\n\t"
        "s_add_u32 m0, m0, 0x1000\n\ts_nop 0\n\tglobal_load_lds_dwordx4 %[a1], %[sa]\n\t"
        "s_add_u32 m0, m0, 0x1000\n\ts_nop 0\n\tglobal_load_lds_dwordx4 %[a2], %[sa]\n\t"
        "s_add_u32 m0, m0, 0x1000\n\ts_nop 0\n\tglobal_load_lds_dwordx4 %[a3], %[sa]\n\t"
        "s_add_u32 m0, m0, 0x1000\n\ts_nop 0\n\tglobal_load_lds_dwordx4 %[b0], %[sb]\n\t"
        "s_add_u32 m0, m0, 0x1000\n\ts_nop 0\n\tglobal_load_lds_dwordx4 %[b1], %[sb]\n\t"
        "s_add_u32 m0, m0, 0x1000\n\ts_nop 0\n\tglobal_load_lds_dwordx4 %[b2], %[sb]\n\t"
        "s_add_u32 m0, m0, 0x1000\n\ts_nop 0\n\tglobal_load_lds_dwordx4 %[b3], %[sb]\n\t"
        "s_mov_b32 m0, %[keep]"
        : [keep] "=&s"(keep)
        : [a0] "v"(va[0]), [a1] "v"(va[1]), [a2] "v"(va[2]), [a3] "v"(va[3]), [b0] "v"(vb[0]), [b1] "v"(vb[1]), [b2] "v"(vb[2]), [b3] "v"(vb[3]),
          [sa] "s"(sa), [sb] "s"(sb), [l] "s"(lds)
        : "memory", "scc");
}
DEVI void glds_tile4(unsigned v0, unsigned v1, const void* sk, const void* sv, unsigned lds) {
    unsigned keep;
    asm volatile(
        "s_mov_b32 %[keep], m0\n\t"
        "s_mov_b32 m0, %[l]\n\ts_nop 0\n\tglobal_load_lds_dwordx4 %[a0], %[sk]\n\t"
        "s_add_u32 m0, m0, 0x1000\n\ts_nop 0\n\tglobal_load_lds_dwordx4 %[a1], %[sk]\n\t"
        "s_add_u32 m0, m0, 0x1000\n\ts_nop 0\n\tglobal_load_lds_dwordx4 %[a0], %[sv]\n\t"
        "s_add_u32 m0, m0, 0x1000\n\ts_nop 0\n\tglobal_load_lds_dwordx4 %[a1], %[sv]\n\t"
        "s_mov_b32 m0, %[keep]"
        : [keep] "=&s"(keep)
        : [a0] "v"(v0), [a1] "v"(v1), [sk] "s"(sk), [sv] "s"(sv), [l] "s"(lds)
        : "memory", "scc");
}
template <bool SWAP, typename RowPtr>
DEVI void gemm_tile(f32x4 (&acc)[4][4], RowPtr rowptr, int kstepA, const bf16_t* __restrict__ Btile, int K, bf16_t* smem, int ldb = 0, bool first_issued = false) {
    if (ldb == 0) ldb = K;
    const int tid = TIDX, lane = tid & 63, wave = wave_(), wr = wave >> 1, wc = wave & 1, l16 = lane & 15, quad = lane >> 4;
#pragma unroll
    for (int i = 0; i < 4; ++i)
#pragma unroll
        for (int j = 0; j < 4; ++j) acc[i][j] = (f32x4){0.f, 0.f, 0.f, 0.f};
    const bf16_t* a0p = rowptr(0);
    unsigned va[4], vb[4];
#pragma unroll
    for (int j = 0; j < 4; ++j) {
        const int R = j * 32 + (tid >> 3), c = (tid & 7) ^ ((R >> 1) & 7);
        va[j] = (unsigned)((const unsigned char*)(rowptr(R) + c * 8) - (const unsigned char*)a0p);
        vb[j] = (unsigned)(((size_t)R * ldb + c * 8) * 2);
    }
    unsigned char* sbase = (unsigned char*)smem;
    const int nk = K >> 6;
    const unsigned lds0 = (unsigned)(size_t)((LAS unsigned char*)sbase) + (unsigned)wave * 1024u;
    auto issue = [&](int kt, int st) {
        glds_tile8(va, vb, a0p + (size_t)kt * kstepA, Btile + (size_t)kt * 64, __builtin_amdgcn_readfirstlane(lds0 + st * 32768));
    };
    const int sw0 = (quad ^ (l16 >> 1)) * 16;
    const int aoffb = (wr * 64 + l16) * 128, boffb = 16384 + (wc * 64 + l16) * 128;
    if (!first_issued) issue(0, 0);
#pragma unroll 1
    for (int kt = 0; kt < nk; ++kt) {
        asm volatile("s_waitcnt vmcnt(0)\n\ts_barrier" ::: "memory");
        if (kt + 1 < nk) issue(kt + 1, (kt + 1) & 1);
        const unsigned char* cs = sbase + (kt & 1) * 32768;
        bf16x8 af0[4], bf0[4], af1[4], bf1[4];
#pragma unroll
        for (int i = 0; i < 4; ++i) { af0[i] = *(const bf16x8*)(cs + aoffb + i * 2048 + sw0); bf0[i] = *(const bf16x8*)(cs + boffb + i * 2048 + sw0); }
#pragma unroll
        for (int i = 0; i < 4; ++i) { af1[i] = *(const bf16x8*)(cs + aoffb + i * 2048 + (sw0 ^ 64)); bf1[i] = *(const bf16x8*)(cs + boffb + i * 2048 + (sw0 ^ 64)); }
        __builtin_amdgcn_sched_barrier(0);
#pragma unroll
        for (int i = 0; i < 4; ++i)
#pragma unroll
            for (int j = 0; j < 4; ++j) acc[i][j] = SWAP ? mfma16(bf0[j], af0[i], acc[i][j]) : mfma16(af0[i], bf0[j], acc[i][j]);
        __builtin_amdgcn_sched_barrier(0);
#pragma unroll
        for (int i = 0; i < 4; ++i)
#pragma unroll
            for (int j = 0; j < 4; ++j) acc[i][j] = SWAP ? mfma16(bf1[j], af1[i], acc[i][j]) : mfma16(af1[i], bf1[j], acc[i][j]);
    }
    __syncthreads();
}

DEVI void gemm_issue0(const bf16_t* Ab, int lda, const bf16_t* Btile, int ldb, bf16_t* smem) {
    const int tid = TIDX, wave = wave_();
    const unsigned lds0 = (unsigned)(size_t)((LAS unsigned char*)smem) + (unsigned)wave * 1024u;
    unsigned va[4], vb[4];
#pragma unroll
    for (int j = 0; j < 4; ++j) {
        const int R = j * 32 + (tid >> 3), c = (tid & 7) ^ ((R >> 1) & 7);
        va[j] = (unsigned)(((size_t)R * lda + c * 8) * 2);
        vb[j] = (unsigned)(((size_t)R * ldb + c * 8) * 2);
    }
    glds_tile8(va, vb, Ab, Btile, __builtin_amdgcn_readfirstlane(lds0));
}

DEVI bool tile_map(int it, int NTN, int& tm, int& tn) {
    const int G = gridDim.x;
    if ((G & 7) != 0) { const int t = blockIdx.x + it * G; if (t >= 128 * NTN) return false; tm = t / NTN; tn = t % NTN; return true; }
    const int x = blockIdx.x & 7, nb = G >> 3, q = it * nb + (blockIdx.x >> 3);
    if (q >= 16 * NTN) return false;
    const int full = NTN >> 3;
    int chunk, qq, w;
    if (q < full * 128) { chunk = q >> 7; qq = q & 127; w = 8; } else { chunk = full; qq = q - full * 128; w = NTN & 7; }
    tm = x * 16 + qq / w; tn = chunk * 8 + qq % w;
    return true;
}

DEVI int win_src_col(int n) { return n < 1536 ? n : (n < 1792 ? 1560 + (n - 1536) : (n < 1816 ? 1536 + (n - 1792) : -1)); }
DEVI int swiglu_src_col(int n) { const int t16 = n >> 4, pair = t16 >> 1, up = t16 & 1; return up * DFF + pair * 16 + (n & 15); }

DEVI void transpose_tile(const float* __restrict__ W, int Nsrc, bf16_t* __restrict__ out, int K, int perm, int tk, int tn, float* tl) {
    const int tid = TIDX;
    {
        const int n4 = (tid & 15) * 4, kr = tid >> 4;
        const int n = tn * 64 + n4;
        const int sc = perm == 1 ? swiglu_src_col(n) : (perm == 2 ? win_src_col(n) : n);
        f32x4 v[4];
#pragma unroll
        for (int i = 0; i < 4; ++i)
            v[i] = sc >= 0 ? *(const f32x4*)(W + (size_t)(tk * 64 + kr + 16 * i) * Nsrc + sc) : (f32x4){0.f, 0.f, 0.f, 0.f};
#pragma unroll
        for (int i = 0; i < 4; ++i)
#pragma unroll
            for (int e = 0; e < 4; ++e) tl[(kr + 16 * i) * 65 + n4 + e] = v[i][e];
    }
    __syncthreads();
    {
        const int k8 = (tid & 7) * 8, nr = tid >> 3;
#pragma unroll
        for (int i = 0; i < 2; ++i) {
            const int nn = nr + 32 * i;
            u32x4 pk;
            pk.x = pk_bf16(tl[(k8 + 0) * 65 + nn], tl[(k8 + 1) * 65 + nn]); pk.y = pk_bf16(tl[(k8 + 2) * 65 + nn], tl[(k8 + 3) * 65 + nn]);
            pk.z = pk_bf16(tl[(k8 + 4) * 65 + nn], tl[(k8 + 5) * 65 + nn]); pk.w = pk_bf16(tl[(k8 + 6) * 65 + nn], tl[(k8 + 7) * 65 + nn]);
            *(u32x4*)(out + (size_t)(tn * 64 + nn) * K + tk * 64 + k8) = pk;
        }
    }
    __syncthreads();
}

DEVI void dsincos(double x, double& s, double& c) {
    const double TWO_PI = 6.283185307179586476925;
    const double k = rint(x / TWO_PI);
    double r = fma(-k, TWO_PI, x);
    r = fma(-k, 2.4492935982947064e-16, r);
    const double y = r * 0.125, y2 = y * y;
    double sn = 1.0, cs = 1.0;
    sn = y * (1.0 + y2 * (-1.0 / 6 + y2 * (1.0 / 120 + y2 * (-1.0 / 5040 + y2 * (1.0 / 362880 + y2 * (-1.0 / 39916800 + y2 * (1.0 / 6227020800.0)))))));
    cs = 1.0 + y2 * (-0.5 + y2 * (1.0 / 24 + y2 * (-1.0 / 720 + y2 * (1.0 / 40320 + y2 * (-1.0 / 3628800 + y2 * (1.0 / 479001600.0 + y2 * (-1.0 / 87178291200.0)))))));
#pragma unroll
    for (int i = 0; i < 3; ++i) { const double s2 = 2.0 * sn * cs, c2 = cs * cs - sn * sn; sn = s2; cs = c2; }
    s = sn; c = cs;
}

DEVI void phase_prologue(const Params& p, unsigned char* smem_raw) {
    unsigned char* ws = p.ws;
    float* tl = (float*)smem_raw;
    constexpr int NTL = 5104, NT_W = 4 * NTL, NHB = 2048, NCS = 256, NCB = 64, NS5 = 64;
    constexpr int NSMALL = NCS + NCB + NS5;
    constexpr int TOTAL = NT_W + NHB + NCS + NCB + NS5;
    const int tid = TIDX;
    for (int item0 = blockIdx.x; item0 < TOTAL; item0 += gridDim.x) {
        const int item = item0 < NSMALL ? item0 + NT_W + NHB : item0 - NSMALL;
        if (item < NT_W) {
            const int l = item / NTL;
            int r = item % NTL;
            const float* W; bf16_t* out; int K, Nsrc, ntn, perm = 0;
            unsigned char* lw = ws + OFF_W + (size_t)l * SZ_LAYER;
            if (r < 1408) { W = p.ffn1_in + (size_t)l * 1024 * 5632; out = (bf16_t*)(lw + OL_W1T0); K = 1024; Nsrc = 5632; ntn = 88; perm = 1; }
            else if (r < 2816) { r -= 1408; W = p.ffn2_in + (size_t)l * 1024 * 5632; out = (bf16_t*)(lw + OL_W1T1); K = 1024; Nsrc = 5632; ntn = 88; perm = 1; }
            else if (r < 3520) { r -= 2816; W = p.ffn1_out + (size_t)l * 2816 * 1024; out = (bf16_t*)(lw + OL_W2T0); K = 2816; Nsrc = 1024; ntn = 16; }
            else if (r < 4224) { r -= 3520; W = p.ffn2_out + (size_t)l * 2816 * 1024; out = (bf16_t*)(lw + OL_W2T1); K = 2816; Nsrc = 1024; ntn = 16; }
            else if (r < 4704) { r -= 4224; W = p.w_in + (size_t)l * 1024 * NINSRC; out = (bf16_t*)(lw + OL_WINT); K = 1024; Nsrc = NINSRC; ntn = 30; perm = 2; }
            else if (r < 4960) { r -= 4704; W = p.w_out + (size_t)l * 1024 * 1024; out = (bf16_t*)(lw + OL_WOUTT); K = 1024; Nsrc = 1024; ntn = 16; }
            else if (r < 5024) { r -= 4960; W = p.ck_w1 + (size_t)l * 2048 * 128; out = (bf16_t*)(lw + OL_CW1K); K = 2048; Nsrc = 128; ntn = 2; }
            else if (r < 5088) { r -= 5024; W = p.cv_w1 + (size_t)l * 2048 * 128; out = (bf16_t*)(lw + OL_CW1V); K = 2048; Nsrc = 128; ntn = 2; }
            else { r -= 5088; W = p.glu_w + (size_t)l * 256 * 256; out = (bf16_t*)(lw + OL_GLUT); K = 256; Nsrc = 256; ntn = 4; }
            transpose_tile(W, Nsrc, out, K, perm, r / ntn, r % ntn, tl);
        } else if (item < NT_W + NHB) {
            const int it = item - NT_W;
            const float* src = p.x + (size_t)it * 8192;
            bf16_t* dst = (bf16_t*)(ws + OFF_HB) + (size_t)it * 8192;
#pragma unroll
            for (int i = 0; i < 4; ++i) {
                const int e = (i * 256 + tid) * 8;
                const float4 a = *(const float4*)(src + e), b = *(const float4*)(src + e + 4);
                uint4 o; o.x = pk_bf16(a.x, a.y); o.y = pk_bf16(a.z, a.w); o.z = pk_bf16(b.x, b.y); o.w = pk_bf16(b.z, b.w);
                *(uint4*)(dst + e) = o;
            }
        } else if (item < NT_W + NHB + NCS) {
            const int it = item - NT_W - NHB;
            float* ct = (float*)(ws + OFF_COS); float* st = (float*)(ws + OFF_SIN);
#pragma unroll
            for (int i = 0; i < 4; ++i) {
                const int e = it * 1024 + i * 256 + tid;
                const int s = e >> 5, d = e & 31;
                const float inv = 1.0f / powf(10000.0f, (float)(2 * d) / 64.0f);
                const float ang = (float)s * inv;
                double sn, cs; dsincos((double)ang, sn, cs);
                ct[e] = (float)cs; st[e] = (float)sn;
            }
        } else if (item < NT_W + NHB + NCS + NCB) {
            const int it = item - NT_W - NHB - NCS;
            const int job = it >> 3, sl = it & 7, l = job >> 1, kv = job & 1;
            const float* pe = (kv ? p.pe_v : p.pe_k) + (size_t)l * 2048;
            const float* w1 = (kv ? p.cv_w1 : p.ck_w1) + (size_t)l * 2048 * 128;
            const int n = tid & 127, half = tid >> 7;
            float s = 0.f;
            const int k0 = sl * 256 + half * 128;
#pragma unroll 16
            for (int k = k0; k < k0 + 128; ++k) s += pe[k] * w1[(size_t)k * 128 + n];
            __syncthreads();
            if (half) tl[n] = s;
            __syncthreads();
            if (!half) ((float*)(ws + OFF_CBIAS))[it * 128 + n] = s + tl[n];
            __syncthreads();
        } else {
            const int it = item - NT_W - NHB - NCS - NCB;
            if (tid < 64) {
                const int sidx = it * 64 + tid;
                const double dt = exp((double)p.log_dt[it]);
                const double lr = p.lam_re[sidx], li = p.lam_im[sidx];
                const double mag = exp(lr * dt);
                double sn, cs; dsincos(li * dt, sn, cs);
                const double ar = mag * cs, ai = mag * sn;
                const double den = lr * lr + li * li;
                const double fr = ((ar - 1.0) * lr + ai * li) / den, fi = (ai * lr - (ar - 1.0) * li) / den;
                const double magL = exp(lr * dt * 64.0);
                double snL, csL; dsincos(li * dt * 64.0, snL, csL);
                float4 a4; a4.x = (float)ar; a4.y = (float)ai; a4.z = (float)(magL * csL); a4.w = (float)(magL * snL);
                ((float4*)(ws + OFF_S5A))[sidx] = a4;
                float* bb = (float*)(ws + OFF_S5B) + (size_t)sidx * 32;
                for (int c = 0; c < 16; ++c) {
                    const double br = p.b_re[(size_t)sidx * 16 + c], bi = p.b_im[(size_t)sidx * 16 + c];
                    bb[c] = (float)(fr * br - fi * bi);
                    bb[16 + c] = (float)(fr * bi + fi * br);
                }
            }
        }
    }
}

DEVI void phase_ffn_in(const Params& p, int l, int which, bf16_t* smem) {
    unsigned char* ws = p.ws;
    const bf16_t* A = (const bf16_t*)(ws + OFF_HB);
    const bf16_t* Bt = (const bf16_t*)(ws + OFF_W + (size_t)l * SZ_LAYER + (which ? OL_W1T1 : OL_W1T0));
    bf16_t* act = (bf16_t*)(ws + OFF_ACT);
    const int lane = TIDX & 63, wave = wave_(), wr = wave >> 1, wc = wave & 1, l16 = lane & 15, quad = lane >> 4;
    int tm, tn;
    bool have = tile_map(0, 44, tm, tn);
    if (have) gemm_issue0(A + (size_t)tm * 128 * 1024, 1024, Bt + (size_t)tn * 128 * 1024, 1024, smem);
    for (int it = 0; have; ++it) {
        f32x4 acc[4][4];
        const bf16_t* Ab = A + (size_t)tm * 128 * 1024;
        gemm_tile<true>(acc, [&](int r) { return Ab + (size_t)r * 1024; }, 64, Bt + (size_t)tn * 128 * 1024, 1024, smem, 0, true);
        int tm2 = 0, tn2 = 0;
        const bool have2 = tile_map(it + 1, 44, tm2, tn2);
        if (have2) gemm_issue0(A + (size_t)tm2 * 128 * 1024, 1024, Bt + (size_t)tn2 * 128 * 1024, 1024, smem);
        const int colb = (tn * 128 + wc * 64) >> 1;
#pragma unroll
        for (int mi = 0; mi < 4; ++mi)
#pragma unroll
            for (int pp = 0; pp < 2; ++pp) {
                float v[4];
#pragma unroll
                for (int r = 0; r < 4; ++r) { const float g = acc[mi][2 * pp][r], u = acc[mi][2 * pp + 1][r]; v[r] = g * u * rcp_(1.0f + fast_exp2(-g * LOG2E)); }
                const int row = tm * 128 + wr * 64 + mi * 16 + l16;
                u32x2 pk; pk.x = pk_bf16(v[0], v[1]); pk.y = pk_bf16(v[2], v[3]);
                *(u32x2*)(act + (size_t)row * DFF + colb + pp * 16 + quad * 4) = pk;
            }
        tm = tm2; tn = tn2; have = have2;
    }
}

DEVI void phase_gemm_res(const Params& p, const bf16_t* A, int K, const bf16_t* Bt, const float* xraw, int lnidx, float bscale, bf16_t* smem) {
    float* hbuf = (float*)(p.ws + OFF_H);
    const f32x2v* stats = (const f32x2v*)(p.ws + OFF_STATS);
    const float* lg = p.ln_g + (size_t)lnidx * D_;
    const float* lb = p.ln_b + (size_t)lnidx * D_;
    const int lane = TIDX & 63, wave = wave_(), wr = wave >> 1, wc = wave & 1, l16 = lane & 15, quad = lane >> 4;
    int tm, tn;
    bool have = tile_map(0, 8, tm, tn);
    if (have) gemm_issue0(A + (size_t)tm * 128 * K, K, Bt + (size_t)tn * 128 * K, K, smem);
    for (int it = 0; have; ++it) {
        f32x4 acc[4][4];
        const bf16_t* Ab = A + (size_t)tm * 128 * K;
        gemm_tile<true>(acc, [&](int r) { return Ab + (size_t)r * K; }, 64, Bt + (size_t)tn * 128 * K, K, smem, 0, true);
        int tm2 = 0, tn2 = 0;
        const bool have2 = tile_map(it + 1, 8, tm2, tn2);
        if (have2) gemm_issue0(A + (size_t)tm2 * 128 * K, K, Bt + (size_t)tn2 * 128 * K, K, smem);
        if (xraw) {
#pragma unroll
            for (int mi = 0; mi < 4; ++mi)
#pragma unroll
                for (int ni = 0; ni < 4; ++ni) {
                    const size_t idx = (size_t)(tm * 128 + wr * 64 + mi * 16 + l16) * D_ + tn * 128 + wc * 64 + ni * 16 + quad * 4;
                    const f32x4 rv = *(const f32x4*)(xraw + idx);
                    *(f32x4*)(hbuf + idx) = rv * ALPHA + acc[mi][ni] * bscale;
                }
        } else {
            f32x4 g4[4], b4[4];
#pragma unroll
            for (int ni = 0; ni < 4; ++ni) {
                const int col = tn * 128 + wc * 64 + ni * 16 + quad * 4;
                g4[ni] = *(const f32x4*)(lg + col) * ALPHA; b4[ni] = *(const f32x4*)(lb + col) * ALPHA;
            }
#pragma unroll
            for (int mi = 0; mi < 4; ++mi) {
                const int row = tm * 128 + wr * 64 + mi * 16 + l16;
                const f32x2v st = stats[row];
#pragma unroll
                for (int ni = 0; ni < 4; ++ni) {
                    const size_t idx = (size_t)row * D_ + tn * 128 + wc * 64 + ni * 16 + quad * 4;
                    const f32x4 rv = *(const f32x4*)(hbuf + idx);
                    *(f32x4*)(hbuf + idx) = ((rv - st[0]) * st[1]) * g4[ni] + b4[ni] + acc[mi][ni] * bscale;
                }
            }
        }
        tm = tm2; tn = tn2; have = have2;
    }
}

DEVI void phase_ln(const Params& p, int l, int which, bool last) {
    float* hbuf = (float*)(p.ws + OFF_H);
    bf16_t* hb = (bf16_t*)(p.ws + OFF_HB);
    float* dst = last ? p.out : hbuf;
    const float* g = p.ln_g + (size_t)(l * 3 + which) * D_;
    const float* b = p.ln_b + (size_t)(l * 3 + which) * D_;
    const int lane = TIDX & 63, wave = wave_();
    const int stride = gridDim.x * 4;
    int row = blockIdx.x * 4 + wave;
    f32x4 nx[4];
    if (row < T_) {
#pragma unroll
        for (int i = 0; i < 4; ++i) nx[i] = *(const f32x4*)(hbuf + (size_t)row * D_ + i * 256 + lane * 4);
    }
    for (; row < T_; row += stride) {
        f32x4 v[4];
#pragma unroll
        for (int i = 0; i < 4; ++i) v[i] = nx[i];
        const int rn = row + stride < T_ ? row + stride : row;
#pragma unroll
        for (int i = 0; i < 4; ++i) nx[i] = *(const f32x4*)(hbuf + (size_t)rn * D_ + i * 256 + lane * 4);
        float s = 0.f;
#pragma unroll
        for (int i = 0; i < 4; ++i) s += (v[i][0] + v[i][1]) + (v[i][2] + v[i][3]);
#pragma unroll
        for (int o = 32; o > 0; o >>= 1) s += __shfl_xor(s, o);
        const float mu = s * (1.0f / 1024.0f);
        float q = 0.f;
#pragma unroll
        for (int i = 0; i < 4; ++i) { const f32x4 d = v[i] - mu; q += (d[0] * d[0] + d[1] * d[1]) + (d[2] * d[2] + d[3] * d[3]); }
#pragma unroll
        for (int o = 32; o > 0; o >>= 1) q += __shfl_xor(q, o);
        const float rstd = rsqrtf(q * (1.0f / 1024.0f) + 1e-5f);
#pragma unroll
        for (int i = 0; i < 4; ++i) {
            const int c0 = i * 256 + lane * 4;
            const f32x4 gg = *(const f32x4*)(g + c0), bb = *(const f32x4*)(b + c0);
            const f32x4 o = (v[i] - mu) * rstd * gg + bb;
            if (last) *(f32x4*)(dst + (size_t)row * D_ + c0) = o;
            else { u32x2 pk; pk.x = pk_bf16(o[0], o[1]); pk.y = pk_bf16(o[2], o[3]); *(u32x2*)(hb + (size_t)row * D_ + c0) = pk; }
        }
        if (!last && lane == 0) ((f32x2v*)(p.ws + OFF_STATS))[row] = (f32x2v){mu, rstd};
    }
}

DEVI void phase_inproj(const Params& p, int l, bf16_t* smem) {
    unsigned char* ws = p.ws;
    const bf16_t* A = (const bf16_t*)(ws + OFF_HB);
    const bf16_t* Bt = (const bf16_t*)(ws + OFF_W + (size_t)l * SZ_LAYER + OL_WINT);
    const float* cosT = (const float*)(ws + OFF_COS);
    const float* sinT = (const float*)(ws + OFF_SIN);
    bf16_t* qo = (bf16_t*)(ws + OFF_Q);
    float* upool = (float*)(ws + OFF_UPOOL);
    float* ussm = (float*)(ws + OFF_USSM);
    float* gates = (float*)(ws + OFF_GATES);
    const int lane = TIDX & 63, wave = wave_(), wr = wave >> 1, wc = wave & 1, l16 = lane & 15, quad = lane >> 4;
    for (int it = 0;; ++it) {
        int tm, tn; if (!tile_map(it, 15, tm, tn)) break;
        f32x4 acc[4][4];
        const bf16_t* Ab = A + (size_t)tm * 128 * 1024;
        const int cb = tn * 128 + wc * 64;
        const int row0 = tm * 128 + wr * 64;
        if (tn == 9 || tn == 11) {
            gemm_tile<false>(acc, [&](int r) { return Ab + (size_t)r * 1024; }, 64, Bt + (size_t)tn * 128 * 1024, 1024, smem);
            const int g = ((cb - 768) >> 6) & 1;
            bf16_t* dst = (bf16_t*)(ws + (tn == 9 ? OFF_VSLCT : OFF_VWINT));
#pragma unroll
            for (int mi = 0; mi < 4; ++mi) {
                const int tok = row0 + mi * 16 + quad * 4, s = tok & (S_ - 1), b = tok >> 13;
                bf16_t* bp = dst + ((size_t)(b * 2 + g) * 128 + (s >> 6)) * 4096 + (((s >> 2) & 3) * 16 + ((s >> 4) & 3) * 4);
#pragma unroll
                for (int ni = 0; ni < 4; ++ni) {
                    u32x2 pk; pk.x = pk_bf16(acc[mi][ni][0], acc[mi][ni][1]); pk.y = pk_bf16(acc[mi][ni][2], acc[mi][ni][3]);
                    *(u32x2*)(bp + (ni * 16 + l16) * 64) = pk;
                }
            }
            continue;
        }
        gemm_tile<true>(acc, [&](int r) { return Ab + (size_t)r * 1024; }, 64, Bt + (size_t)tn * 128 * 1024, 1024, smem);
        if (cb < 256 || (cb >= 1536 && cb < 1792)) {
            float* dst = cb < 256 ? (upool + cb) : (ussm + (cb - 1536));
#pragma unroll
            for (int mi = 0; mi < 4; ++mi)
#pragma unroll
                for (int ni = 0; ni < 4; ++ni) *(f32x4*)(dst + (size_t)(row0 + mi * 16 + l16) * 256 + ni * 16 + quad * 4) = acc[mi][ni];
        } else if (cb < 1536) {
            const bool isq = cb < 768;
            const int kvi = isq ? -1 : (cb - 768) >> 7, g = isq ? 0 : ((cb - 768) >> 6) & 1;
#pragma unroll
            for (int mi = 0; mi < 4; ++mi) {
                const int tok = row0 + mi * 16 + l16, s = tok & (S_ - 1), b = tok >> 13;
                bf16_t* base;
                if (isq) base = qo + (size_t)tok * 512 + ((cb - 256) >> 6) * 64;
                else if (kvi == 0) base = (bf16_t*)(ws + OFF_KCMP) + (size_t)tok * 128 + g * 64;
                else if (kvi == 1) base = (bf16_t*)(ws + OFF_VCMP) + (size_t)tok * 128 + g * 64;
                else base = (bf16_t*)(ws + (kvi == 2 ? OFF_KSLC : OFF_KWIN)) + ((size_t)(b * 2 + g) * S_ + s) * 64;
                if (kvi == 1) {
#pragma unroll
                    for (int ni = 0; ni < 4; ++ni) {
                        u32x2 pk; pk.x = pk_bf16(acc[mi][ni][0], acc[mi][ni][1]); pk.y = pk_bf16(acc[mi][ni][2], acc[mi][ni][3]);
                        *(u32x2*)(base + ni * 16 + quad * 4) = pk;
                    }
                } else {
                    const float sc = isq ? 0.125f : 1.0f;
#pragma unroll
                    for (int ni = 0; ni < 2; ++ni) {
                        const int d0 = ni * 16 + quad * 4;
                        const f32x4 c4 = *(const f32x4*)(cosT + s * 32 + d0), s4 = *(const f32x4*)(sinT + s * 32 + d0);
                        const f32x4 x1 = acc[mi][ni], x2 = acc[mi][ni + 2];
                        const f32x4 o1 = (x1 * c4 - x2 * s4) * sc, o2 = (x2 * c4 + x1 * s4) * sc;
                        u32x2 p1, p2;
                        p1.x = pk_bf16(o1[0], o1[1]); p1.y = pk_bf16(o1[2], o1[3]);
                        p2.x = pk_bf16(o2[0], o2[1]); p2.y = pk_bf16(o2[2], o2[3]);
                        *(u32x2*)(base + d0) = p1;
                        *(u32x2*)(base + d0 + 32) = p2;
                    }
                }
            }
        } else if (cb == 1792) {
#pragma unroll
            for (int mi = 0; mi < 4; ++mi)
#pragma unroll
                for (int ni = 0; ni < 2; ++ni) {
                    const int c0 = ni * 16 + quad * 4;
                    if (c0 < 24) {
                        f32x4 gv;
#pragma unroll
                        for (int r = 0; r < 4; ++r) gv[r] = sigmoidf_(acc[mi][ni][r]);
                        *(f32x4*)(gates + (size_t)(row0 + mi * 16 + l16) * 24 + c0) = gv;
                    }
                }
        }
    }
}

DEVI void compress_partial(const Params& p, int l, int kv, int tmc, int ks, bf16_t* smem) {
    unsigned char* ws = p.ws;
    const bf16_t* src = (const bf16_t*)(ws + (kv ? OFF_VCMP : OFF_KCMP));
    const bf16_t* Bt = (const bf16_t*)(ws + OFF_W + (size_t)l * SZ_LAYER + (kv ? OL_CW1V : OL_CW1K)) + ks * 512;
    float* hp = (float*)(ws + OFF_HIDP) + ((size_t)(ks * 2 + kv) * 2048 + tmc * 128) * 128;
    const int tid = TIDX, lane = tid & 63, wave = wave_(), wr = wave >> 1, wc = wave & 1, l16 = lane & 15, quad = lane >> 4;
    f32x4 acc[4][4];
    gemm_tile<true>(acc, [&](int r) {
        const int row = tmc * 128 + r, bg = row >> 9, c = row & 511;
        return src + ((size_t)((bg >> 1) * S_ + c * 16 + ks * 8)) * 128 + (bg & 1) * 64; }, 128, Bt, 512, smem, 2048);
#pragma unroll
    for (int mi = 0; mi < 4; ++mi)
#pragma unroll
        for (int ni = 0; ni < 4; ++ni) *(f32x4*)(hp + (size_t)(wr * 64 + mi * 16 + l16) * 128 + wc * 64 + ni * 16 + quad * 4) = acc[mi][ni];
}

DEVI void compress_finish(const Params& p, int l, int kv, int t32, float* sm) {
    unsigned char* ws = p.ws;
    const float* bias = (const float*)(ws + OFF_CBIAS) + (l * 2 + kv) * 8 * 128;
    const float* w2 = (kv ? p.cv_w2 : p.ck_w2) + (size_t)l * 128 * 64;
    const float* hp = (const float*)(ws + OFF_HIDP) + ((size_t)kv * 2048 + t32 * 32) * 128;
    float* hid = sm;
    float* w2s = sm + 32 * 129 + 3;
    w2s = sm + 4160;
    const int tid = TIDX;
#pragma unroll
    for (int i = 0; i < 8; ++i) *(f32x4*)(w2s + (i * 256 + tid) * 4) = *(const f32x4*)(w2 + (i * 256 + tid) * 4);
#pragma unroll
    for (int i = 0; i < 4; ++i) {
        const int e = (i * 256 + tid) * 4, row = e >> 7, col = e & 127;
        f32x4 v = *(const f32x4*)(bias + col);
#pragma unroll
        for (int sl = 1; sl < 8; ++sl) v += *(const f32x4*)(bias + sl * 128 + col);
#pragma unroll
        for (int ks = 0; ks < 4; ++ks) v += *(const f32x4*)(hp + (size_t)ks * 2 * 2048 * 128 + (size_t)row * 128 + col);
#pragma unroll
        for (int r = 0; r < 4; ++r) hid[row * 129 + col + r] = gelu_tanh(v[r]);
    }
    __syncthreads();
    {
        const int d = tid & 63, rq = tid >> 6;
        float o[8];
#pragma unroll
        for (int i = 0; i < 8; ++i) o[i] = 0.f;
#pragma unroll 4
        for (int n = 0; n < 128; ++n) {
            const float w = w2s[n * 64 + d];
#pragma unroll
            for (int i = 0; i < 8; ++i) o[i] += hid[(rq * 8 + i) * 129 + n] * w;
        }
        if (!kv) {
            bf16_t* kc = (bf16_t*)(ws + OFF_KC);
#pragma unroll
            for (int i = 0; i < 8; ++i) kc[(size_t)(t32 * 32 + rq * 8 + i) * 64 + d] = f2bf(o[i]);
        } else {
            bf16_t* vct = (bf16_t*)(ws + OFF_VCT);
#pragma unroll
            for (int i = 0; i < 8; ++i) {
                const int row = t32 * 32 + rq * 8 + i, bg = row >> 9, c = row & 511;
                vct[((size_t)(bg * 8 + (c >> 6)) * 64 + d) * 64 + (((c >> 2) & 3) * 16 + ((c >> 4) & 3) * 4 + (c & 3))] = f2bf(o[i]);
            }
        }
    }
    __syncthreads();
}

DEVI void phase_m2b(const Params& p, int l, unsigned char* smem) {
    for (int item = blockIdx.x; item < 128; item += gridDim.x) compress_finish(p, l, item >> 6, item & 63, (float*)smem);
}

DEVI void pool_item(const Params& p, int l, int tp, int gi, float* sm) {
    unsigned char* ws = p.ws;
    const float* upool = (const float*)(ws + OFF_UPOOL);
    bf16_t* cat = (bf16_t*)(ws + OFF_CAT);
    float* ul = sm;
    bf16_t* pb = (bf16_t*)(sm + 80 * 64);
    bf16_t* wt = pb + 64 * 72;
    const int tid = TIDX, lane = tid & 63, wave = wave_(), l16 = lane & 15, quad = lane >> 4;
    const int tok0 = tp * 64, s0 = tok0 & (S_ - 1);
    const int w = 2 << gi;
#pragma unroll
    for (int i = 0; i < 5; ++i) {
        const int idx = i * 256 + tid, row = idx >> 4, c4 = (idx & 15) * 4;
        const int sidx = s0 - 16 + row;
        const f32x4 v = sidx >= 0 ? *(const f32x4*)(upool + (size_t)(tok0 - 16 + row) * 256 + gi * 64 + c4) : (f32x4){0.f, 0.f, 0.f, 0.f};
        *(f32x4*)(ul + row * 64 + c4) = v;
    }
    {
        const float* wp = p.pool_w + ((size_t)(l * 4 + gi) * 64) * 64;
#pragma unroll
        for (int i = 0; i < 4; ++i) {
            const int idx = i * 256 + tid, c = idx >> 4, d4 = (idx & 15) * 4;
            const f32x4 v = *(const f32x4*)(wp + c * 64 + d4);
#pragma unroll
            for (int e = 0; e < 4; ++e) wt[(d4 + e) * 72 + c] = f2bf(v[e]);
        }
    }
    __syncthreads();
    {
        const int c = tid & 63, t0 = (tid >> 6) * 16;
        float sum = 0.f;
        for (int k = 0; k < w; ++k) sum += ul[(16 + t0 - k) * 64 + c];
#pragma unroll 4
        for (int i = 0; i < 16; ++i) {
            const int t = t0 + i;
            if (i > 0) sum += ul[(16 + t) * 64 + c] - ul[(16 + t - w) * 64 + c];
            const int sq = s0 + t;
            const float div = (float)(sq + 1 < w ? sq + 1 : w);
            pb[t * 72 + c] = f2bf(sum / div - ul[(16 + t) * 64 + c]);
        }
    }
    __syncthreads();
    {
        f32x4 acc[4];
#pragma unroll
        for (int nt = 0; nt < 4; ++nt) acc[nt] = (f32x4){0.f, 0.f, 0.f, 0.f};
#pragma unroll
        for (int ks = 0; ks < 2; ++ks) {
            const bf16x8 af = *(const bf16x8*)(pb + (wave * 16 + l16) * 72 + ks * 32 + quad * 8);
#pragma unroll
            for (int nt = 0; nt < 4; ++nt) {
                const bf16x8 bfr = *(const bf16x8*)(wt + (nt * 16 + l16) * 72 + ks * 32 + quad * 8);
                acc[nt] = mfma16(bfr, af, acc[nt]);
            }
        }
        const float* sc = p.pool_scale + l * 256 + gi * 64;
        bf16_t* dst = cat + (size_t)(tok0 + wave * 16 + l16) * 1024 + gi * 64;
#pragma unroll
        for (int nt = 0; nt < 4; ++nt) {
            const f32x4 s4 = *(const f32x4*)(sc + nt * 16 + quad * 4);
            const f32x4 o = acc[nt] * s4;
            u32x2 pk; pk.x = pk_bf16(o[0], o[1]); pk.y = pk_bf16(o[2], o[3]);
            *(u32x2*)(dst + nt * 16 + quad * 4) = pk;
        }
    }
    __syncthreads();
}

DEVI void s5_load_u(const float* ussm, int tok0, int G, float* us, int lane) {
    const float* up = ussm + (size_t)(tok0 + lane) * 256 + G * 16;
#pragma unroll
    for (int i = 0; i < 4; ++i) *(f32x4*)(us + lane * 16 + i * 4) = *(const f32x4*)(up + i * 4);
}

DEVI void s5_bfrags(const Params& p, int l, int G, bf16x8 (&bf)[8]) {
    const int lane = TIDX & 63, l16 = lane & 15, quad = lane >> 4;
    const float* S5B = (const float*)(p.ws + OFF_S5B);
#pragma unroll
    for (int nt = 0; nt < 8; ++nt) {
        const int n = nt * 16 + l16, pp = n & 63, im = n >> 6;
        const float* src = S5B + ((size_t)(l * 16 + G) * 64 + pp) * 32 + im * 16 + (quad & 1) * 8;
        const f32x4 a = *(const f32x4*)src, c = *(const f32x4*)(src + 4);
        u32x4 v = (u32x4){pk_bf16(a[0], a[1]), pk_bf16(a[2], a[3]), pk_bf16(c[0], c[1]), pk_bf16(c[2], c[3])};
        if (quad >= 2) v = (u32x4){0u, 0u, 0u, 0u};
        bf[nt] = __builtin_bit_cast(bf16x8, v);
    }
}
DEVI void s5_x_half(const float* us, bf16_t* XH, const bf16x8 (&bf)[8], int half) {
    const int lane = TIDX & 63, l16 = lane & 15, quad = lane >> 4;
#pragma unroll
    for (int mt = 0; mt < 2; ++mt) {
        const float* up = us + (half * 32 + mt * 16 + l16) * 16 + (quad & 1) * 8;
        const f32x4 a = *(const f32x4*)up, c = *(const f32x4*)(up + 4);
        u32x4 v = (u32x4){pk_bf16(a[0], a[1]), pk_bf16(a[2], a[3]), pk_bf16(c[0], c[1]), pk_bf16(c[2], c[3])};
        if (quad >= 2) v = (u32x4){0u, 0u, 0u, 0u};
        const bf16x8 af = __builtin_bit_cast(bf16x8, v);
#pragma unroll
        for (int nt = 0; nt < 8; ++nt) {
            const f32x4 acc = mfma16(af, bf[nt], (f32x4){0.f, 0.f, 0.f, 0.f});
#pragma unroll
            for (int r = 0; r < 4; ++r) XH[(mt * 16 + quad * 4 + r) * 136 + nt * 16 + l16] = f2bf(acc[r]);
        }
    }
}
DEVI float bf2f(bf16_t v) { return __uint_as_float((unsigned)v << 16); }

DEVI void s5_pass_a(const Params& p, int l, int witem, float* wl) {
    unsigned char* ws = p.ws;
    const int lane = TIDX & 63;
    const int G = witem & 15, k = (witem >> 4) & 127, b = witem >> 11;
    const int sidx = (l * 16 + G) * 64 + lane;
    const float4 a4 = ((const float4*)(ws + OFF_S5A))[sidx];
    bf16x8 bfr[8];
    s5_bfrags(p, l, G, bfr);
    float* us = wl;
    s5_load_u((const float*)(ws + OFF_USSM), b * S_ + k * 64, G, us, lane);
    __builtin_amdgcn_fence(__ATOMIC_RELEASE, "wavefront");
    __builtin_amdgcn_wave_barrier();
    __builtin_amdgcn_fence(__ATOMIC_ACQUIRE, "wavefront");
    bf16_t* XH = (bf16_t*)(wl + 1024);
    float hr = 0.f, hi = 0.f;
    for (int half = 0; half < 2; ++half) {
        s5_x_half(us, XH, bfr, half);
        __builtin_amdgcn_fence(__ATOMIC_RELEASE, "wavefront");
        __builtin_amdgcn_wave_barrier();
        __builtin_amdgcn_fence(__ATOMIC_ACQUIRE, "wavefront");
#pragma unroll 4
        for (int tt = 0; tt < 32; ++tt) {
            const float xr = bf2f(XH[tt * 136 + lane]), xi = bf2f(XH[tt * 136 + 64 + lane]);
            const float nr = a4.x * hr - a4.y * hi + xr, ni = a4.x * hi + a4.y * hr + xi;
            hr = nr; hi = ni;
        }
        __builtin_amdgcn_fence(__ATOMIC_RELEASE, "wavefront");
        __builtin_amdgcn_wave_barrier();
        __builtin_amdgcn_fence(__ATOMIC_ACQUIRE, "wavefront");
    }
    float2* E = (float2*)(ws + OFF_E);
    E[((size_t)(b * 128 + k) * 16 + G) * 64 + lane] = make_float2(hr, hi);
    __builtin_amdgcn_wave_barrier();
}

DEVI void phase_m2(const Params& p, int l, unsigned char* smem) {
    constexpr int NCMP = 128, NPOOL = 1024, NS5 = 1024;
    for (int item = blockIdx.x; item < NCMP + NPOOL + NS5; item += gridDim.x) {
        __syncthreads();
        if (item < NCMP) compress_partial(p, l, (item >> 4) & 1, item & 15, item >> 5, (bf16_t*)smem);
        else if (item < NCMP + NPOOL) { const int it = item - NCMP; pool_item(p, l, it >> 2, it & 3, (float*)smem); }
        else { const int it = item - NCMP - NPOOL; const int wv = wave_(); s5_pass_a(p, l, it * 4 + wv, (float*)(smem + wv * 16384)); }
    }
}

DEVI void s5_pass_b(const Params& p, int l, int witem, unsigned char* wlraw) {
    unsigned char* ws = p.ws;
    const int lane = TIDX & 63, l16 = lane & 15, quad = lane >> 4;
    const int G = witem & 15, k = (witem >> 4) & 127, b = witem >> 11;
    const int sidx = (l * 16 + G) * 64 + lane;
    const float4 a4 = ((const float4*)(ws + OFF_S5A))[sidx];
    bf16x8 bfr[8];
    s5_bfrags(p, l, G, bfr);
    float* us = (float*)wlraw;
    bf16_t* Hs = (bf16_t*)(wlraw + 4096);
    const int tok0 = b * S_ + k * 64;
    s5_load_u((const float*)(ws + OFF_USSM), tok0, G, us, lane);
    float hr = 0.f, hi = 0.f;
    {
        const float2* E = (const float2*)(ws + OFF_E) + ((size_t)(b * 128) * 16 + G) * 64 + lane;
#pragma unroll 8
        for (int kk = 0; kk < k; ++kk) {
            const float2 e = E[(size_t)kk * 16 * 64];
            const float nr = a4.z * hr - a4.w * hi + e.x, ni = a4.z * hi + a4.w * hr + e.y;
            hr = nr; hi = ni;
        }
    }
    bf16x8 cf[4];
    {
        const float* cre = p.c_re + ((size_t)(l * 16 + G) * 16 + l16) * 64 + quad * 8;
        const float* cim = p.c_im + ((size_t)(l * 16 + G) * 16 + l16) * 64 + quad * 8;
#pragma unroll
        for (int ks = 0; ks < 4; ++ks) {
            const float* sp = (ks < 2 ? cre : cim) + (ks & 1) * 32;
            const float sg = ks < 2 ? 1.f : -1.f;
            const float4 a = *(const float4*)sp, c = *(const float4*)(sp + 4);
            union { bf16x8 v; unsigned u[4]; } cv;
            cv.u[0] = pk_bf16(sg * a.x, sg * a.y); cv.u[1] = pk_bf16(sg * a.z, sg * a.w); cv.u[2] = pk_bf16(sg * c.x, sg * c.y); cv.u[3] = pk_bf16(sg * c.z, sg * c.w);
            cf[ks] = cv.v;
        }
    }
    const float dsk = p.ssm_d[(l * 16 + G) * 16 + l16];
    bf16_t* yg = (bf16_t*)(ws + OFF_YG);
    __builtin_amdgcn_fence(__ATOMIC_RELEASE, "wavefront");
    __builtin_amdgcn_wave_barrier();
    __builtin_amdgcn_fence(__ATOMIC_ACQUIRE, "wavefront");
    for (int half = 0; half < 2; ++half) {
        s5_x_half(us, Hs, bfr, half);
        __builtin_amdgcn_fence(__ATOMIC_RELEASE, "wavefront");
        __builtin_amdgcn_wave_barrier();
        __builtin_amdgcn_fence(__ATOMIC_ACQUIRE, "wavefront");
#pragma unroll 4
        for (int tt = 0; tt < 32; ++tt) {
            const float xr = bf2f(Hs[tt * 136 + lane]), xi = bf2f(Hs[tt * 136 + 64 + lane]);
            const float nr = a4.x * hr - a4.y * hi + xr, ni = a4.x * hi + a4.y * hr + xi;
            hr = nr; hi = ni;
            Hs[tt * 136 + lane] = f2bf(hr);
            Hs[tt * 136 + 64 + lane] = f2bf(hi);
        }
        __builtin_amdgcn_fence(__ATOMIC_RELEASE, "wavefront");
        __builtin_amdgcn_wave_barrier();
        __builtin_amdgcn_fence(__ATOMIC_ACQUIRE, "wavefront");
        f32x4 y[2];
#pragma unroll
        for (int mt = 0; mt < 2; ++mt) {
            y[mt] = (f32x4){0.f, 0.f, 0.f, 0.f};
#pragma unroll
            for (int ks = 0; ks < 4; ++ks) {
                const bf16x8 hf = *(const bf16x8*)(Hs + (mt * 16 + l16) * 136 + ks * 32 + quad * 8);
                y[mt] = mfma16(hf, cf[ks], y[mt]);
            }
        }
#pragma unroll
        for (int mt = 0; mt < 2; ++mt)
#pragma unroll
            for (int r = 0; r < 4; ++r) {
                const int t = half * 32 + mt * 16 + quad * 4 + r;
                const float yy = y[mt][r] + dsk * us[t * 16 + l16];
                yg[(size_t)(tok0 + t) * 256 + G * 16 + l16] = f2bf(gelu_tanh(yy));
            }
        __builtin_amdgcn_fence(__ATOMIC_RELEASE, "wavefront");
        __builtin_amdgcn_wave_barrier();
        __builtin_amdgcn_fence(__ATOMIC_ACQUIRE, "wavefront");
    }
}

constexpr int AT_ROW = 72;
constexpr int AT_TILE = 64 * AT_ROW;
DEVI void attn_item(const Params& p, int bg, int t0, unsigned char* smem) {
    unsigned char* ws = p.ws;
    const int tid = TIDX, lane = tid & 63, wave = wave_(), l16 = lane & 15, quad = lane >> 4;
    const int b = bg >> 1, g = bg & 1, r = l16 & 3;
    float* imp = (float*)(smem + 32768) + wave * 2096;
    float* impe = imp + 1024;
    unsigned* selw = (unsigned*)(imp + 2048);
    unsigned* anyw = selw + 32;
    int tq[2];
    tq[0] = t0 + wave * 8 + (l16 >> 2); tq[1] = tq[0] + 4;
    bf16x8 qf[2][2];
    float g_cmp[2], g_slc[2], g_win[2];
#pragma unroll
    for (int ct = 0; ct < 2; ++ct) {
        const size_t tok = (size_t)b * S_ + tq[ct];
        const bf16_t* qp = (const bf16_t*)(ws + OFF_Q) + tok * 512 + (g * 4 + r) * 64 + quad * 8;
        qf[ct][0] = *(const bf16x8*)qp; qf[ct][1] = *(const bf16x8*)(qp + 32);
        const float* gp = (const float*)(ws + OFF_GATES) + tok * 24 + (g * 4 + r) * 3;
        g_cmp[ct] = gp[0]; g_slc[ct] = gp[1]; g_win[ct] = gp[2];
    }
#pragma unroll
    for (int i = 0; i < 32; ++i) imp[i * 64 + lane] = 0.f;
    const bf16_t* kc = (const bf16_t*)(ws + OFF_KC) + (size_t)bg * 512 * 64;
    const bf16_t* vct = (const bf16_t*)(ws + OFF_VCT) + (size_t)bg * 8 * 4096;
    const bf16_t* ksl = (const bf16_t*)(ws + OFF_KSLC) + (size_t)bg * S_ * 64;
    const bf16_t* vsl = (const bf16_t*)(ws + OFF_VSLCT) + (size_t)bg * 128 * 4096;
    const bf16_t* kwn = (const bf16_t*)(ws + OFF_KWIN) + (size_t)bg * S_ * 64;
    const bf16_t* vwn = (const bf16_t*)(ws + OFF_VWINT) + (size_t)bg * 128 * 4096;
    const int tmax = t0 + 31;
    const int ncb = tmax >= 31 ? (((tmax - 31) >> 4) >> 6) + 1 : 0;
    const int cur = t0 >> 6;
    const int nsl = cur + 1;
    const int jlo = (t0 - 511 > 0 ? t0 - 511 : 0) >> 6;
    const int nwn = cur - jlo + 1;
    const int n1 = ncb, n2 = 2 * ncb, n3 = n2 + nsl, ntot = n3 + nwn;
    auto tile_ptrs = [&](int n, const bf16_t*& kp, const bf16_t*& vp) {
        if (n < n2) { const int c = n < n1 ? n : n - n1; kp = kc + (size_t)c * 4096; vp = vct + (size_t)c * 4096; }
        else if (n < n3) { const int j = n - n2; kp = ksl + (size_t)j * 4096; vp = vsl + (size_t)j * 4096; }
        else { const int j = jlo + (n - n3); kp = kwn + (size_t)j * 4096; vp = vwn + (size_t)j * 4096; }
    };
    unsigned gv0, gv1;
    {
        const int R0 = tid >> 3, R1 = 32 + (tid >> 3);
        gv0 = (unsigned)(R0 * 128 + (((tid & 7) ^ ((R0 >> 1) & 7)) * 16));
        gv1 = (unsigned)(R1 * 128 + (((tid & 7) ^ ((R1 >> 1) & 7)) * 16));
    }
    const unsigned alds0 = (unsigned)(size_t)((LAS unsigned char*)smem) + (unsigned)wave * 1024u;
    {
        const bf16_t *kp, *vp; tile_ptrs(0, kp, vp);
        glds_tile4(gv0, gv1, kp, vp, __builtin_amdgcn_readfirstlane(alds0));
    }
    const int rsw = l16 >> 1;
    f32x4 outacc[2][4], o[2][4];
    float m[2], lsum[2], invl[2];
    f32x4 lacc[2];
    const bf16x8 ones8 = __builtin_bit_cast(bf16x8, (u32x4){0x3f803f80u, 0x3f803f80u, 0x3f803f80u, 0x3f803f80u});
#pragma unroll
    for (int ct = 0; ct < 2; ++ct) {
        m[ct] = NEGBIG; lsum[ct] = 0.f; invl[ct] = 0.f; lacc[ct] = (f32x4){0.f, 0.f, 0.f, 0.f};
#pragma unroll
        for (int i = 0; i < 4; ++i) { outacc[ct][i] = (f32x4){0.f, 0.f, 0.f, 0.f}; o[ct][i] = (f32x4){0.f, 0.f, 0.f, 0.f}; }
    }
    const float NINF = -__builtin_inff();
    auto finalize = [&](const float (&gate)[2], bool normalise) {
#pragma unroll
        for (int ct = 0; ct < 2; ++ct) {
            float sc = gate[ct];
            if (normalise) { const float l = lacc[ct][0]; sc = l > 0.f ? gate[ct] / l : 0.f; }
#pragma unroll
            for (int i = 0; i < 4; ++i) { outacc[ct][i] += o[ct][i] * sc; o[ct][i] = (f32x4){0.f, 0.f, 0.f, 0.f}; }
            m[ct] = NEGBIG; lsum[ct] = 0.f; lacc[ct] = (f32x4){0.f, 0.f, 0.f, 0.f};
        }
    };
    auto trans = [&](const int n) {
        if (n == n1 && n1 > 0) {
#pragma unroll
            for (int ct = 0; ct < 2; ++ct) { float l = lsum[ct]; l += __shfl_xor(l, 16); l += __shfl_xor(l, 32); invl[ct] = l > 0.f ? 1.0f / l : 0.f; }
        }
        if (n == n2) {
            if (n1 > 0) finalize(g_cmp, false);
            else { m[0] = m[1] = NEGBIG; lsum[0] = lsum[1] = 0.f; }
            __builtin_amdgcn_fence(__ATOMIC_RELEASE, "wavefront");
            __builtin_amdgcn_wave_barrier();
            __builtin_amdgcn_fence(__ATOMIC_ACQUIRE, "wavefront");
            const int q8 = lane >> 3, jb = (lane & 7) * 16;
            const int tqq = t0 + wave * 8 + q8;
            float v[16];
#pragma unroll
            for (int i4 = 0; i4 < 4; ++i4) {
                const f32x4 x = *(const f32x4*)(imp + q8 * 128 + jb + i4 * 4);
                const int jm = jb + i4 * 4 - 1;
                const float ep = jm >= 0 ? impe[q8 * 128 + jm] : 0.f;
                const f32x4 ex = (f32x4){ep, impe[q8 * 128 + jm + 1], impe[q8 * 128 + jm + 2], impe[q8 * 128 + jm + 3]};
#pragma unroll
                for (int e = 0; e < 4; ++e) {
                    const int j = jb + i4 * 4 + e;
                    float iv = x[e] + ex[e];
                    const bool forced = (j == 0) || (j == cur) || (j == cur - 1);
                    if (forced) iv += 1e4f;
                    if (64 * j > tqq) iv = NEGBIG;
                    v[i4 * 4 + e] = iv;
                }
            }
            unsigned selbits = 0;
#pragma unroll 1
            for (int round = 0; round < 16; ++round) {
                float bv = v[0]; int bi = 0;
#pragma unroll
                for (int i = 1; i < 16; ++i) { const bool gt = v[i] > bv; bv = gt ? v[i] : bv; bi = gt ? i : bi; }
                int gi = jb + bi;
#define TOPK_STEP(CTRL) { \
                    const float ov = __int_as_float(__builtin_amdgcn_update_dpp(0, __float_as_int(bv), (CTRL), 0xf, 0xf, false)); \
                    const int oi = __builtin_amdgcn_update_dpp(0, gi, (CTRL), 0xf, 0xf, false); \
                    const bool take = (ov > bv) || (ov == bv && oi < gi); \
                    bv = take ? ov : bv; gi = take ? oi : gi; }
                TOPK_STEP(0xB1)
                TOPK_STEP(0x4E)
                TOPK_STEP(0x141)
#undef TOPK_STEP
                const bool mine = (gi >> 4) == (lane & 7);
                const int li = gi & 15;
                if (mine && bv > -1e29f) selbits |= 1u << li;
#pragma unroll
                for (int i = 0; i < 16; ++i) v[i] = (mine && i == li) ? NINF : v[i];
            }
            unsigned wv = selbits << ((lane & 1) * 16);
            wv |= __shfl_xor(wv, 1);
            if ((lane & 1) == 0) selw[q8 * 4 + ((lane & 7) >> 1)] = wv;
            __builtin_amdgcn_fence(__ATOMIC_RELEASE, "wavefront");
            __builtin_amdgcn_wave_barrier();
            __builtin_amdgcn_fence(__ATOMIC_ACQUIRE, "wavefront");
#pragma unroll
            for (int ct = 0; ct < 2; ++ct)
#pragma unroll
                for (int w = 0; w < 4; ++w) {
                    const unsigned a = selw[(ct * 4 + 0) * 4 + w] | selw[(ct * 4 + 1) * 4 + w] | selw[(ct * 4 + 2) * 4 + w] | selw[(ct * 4 + 3) * 4 + w];
                    if (lane == 0) anyw[ct * 4 + w] = a;
                }
            __builtin_amdgcn_fence(__ATOMIC_RELEASE, "wavefront");
            __builtin_amdgcn_wave_barrier();
            __builtin_amdgcn_fence(__ATOMIC_ACQUIRE, "wavefront");
        }
        if (n == n3) finalize(g_slc, true);
    };
    auto body = [&](auto kc, const int n) {
        constexpr int KIND = decltype(kc)::value;
        asm volatile("s_waitcnt vmcnt(0)\n\ts_barrier" ::: "memory");
        if (n + 1 < ntot) {
            const bf16_t *kp, *vp; tile_ptrs(n + 1, kp, vp);
            glds_tile4(gv0, gv1, kp, vp, __builtin_amdgcn_readfirstlane(alds0 + ((n + 1) & 1) * 16384));
        }
        const unsigned char* cK = smem + (n & 1) * 16384;
        const unsigned char* cV = cK + 8192;
        constexpr bool is_p1 = KIND == 0, is_p2 = KIND == 1, is_slc = KIND == 2 || KIND == 4;
        const int jt = is_slc ? n - n2 : jlo + (n - n3);
        constexpr bool elem = KIND == 3 || KIND == 4;
        const int wlim = is_slc ? 0x40000000 : 512;
        const int c0 = (is_p1 ? n : n - n1) * 64;
        bool any_act = true;
        if (is_slc && !elem) {
            const unsigned aw = __builtin_amdgcn_readfirstlane(anyw[jt >> 5] | anyw[4 + (jt >> 5)]);
            any_act = (aw >> (jt & 31)) & 1u;
        }
        if (any_act) {
            f32x4 s[2][4];
            {
                bf16x8 k0[4], k1[4];
#pragma unroll
                for (int mt = 0; mt < 4; ++mt) {
                    k0[mt] = *(const bf16x8*)(cK + (mt * 16 + l16) * 128 + ((quad ^ rsw) * 16));
                    k1[mt] = *(const bf16x8*)(cK + (mt * 16 + l16) * 128 + (((4 + quad) ^ rsw) * 16));
                }
#pragma unroll
                for (int mt = 0; mt < 4; ++mt)
#pragma unroll
                    for (int ct = 0; ct < 2; ++ct) s[ct][mt] = mfma16(k0[mt], qf[ct][0], (f32x4){0.f, 0.f, 0.f, 0.f});
#pragma unroll
                for (int mt = 0; mt < 4; ++mt)
#pragma unroll
                    for (int ct = 0; ct < 2; ++ct) s[ct][mt] = mfma16(k1[mt], qf[ct][1], s[ct][mt]);
            }
            if (is_p1) {
                float bm[2];
#pragma unroll
                for (int ct = 0; ct < 2; ++ct) {
                    bm[ct] = NINF;
#pragma unroll
                    for (int mt = 0; mt < 4; ++mt)
#pragma unroll
                        for (int rr = 0; rr < 4; ++rr) {
                            const int c = c0 + mt * 16 + quad * 4 + rr;
                            const float x = (16 * c + 31 <= tq[ct]) ? s[ct][mt][rr] * LOG2E : NINF;
                            s[ct][mt][rr] = x; bm[ct] = fmaxf(bm[ct], x);
                        }
                }
#pragma unroll
                for (int ct = 0; ct < 2; ++ct) bm[ct] = fmaxf(bm[ct], __shfl_xor(bm[ct], 16));
#pragma unroll
                for (int ct = 0; ct < 2; ++ct) bm[ct] = fmaxf(bm[ct], __shfl_xor(bm[ct], 32));
#pragma unroll
                for (int ct = 0; ct < 2; ++ct) {
                    const float mn = fmaxf(m[ct], bm[ct]);
                    float ls = 0.f;
#pragma unroll
                    for (int mt = 0; mt < 4; ++mt)
#pragma unroll
                        for (int rr = 0; rr < 4; ++rr) ls += fast_exp2(s[ct][mt][rr] - mn);
                    lsum[ct] = lsum[ct] * fast_exp2(m[ct] - mn) + ls;
                    m[ct] = mn;
                }
            } else {
                if (is_p2) {
#pragma unroll
                    for (int ct = 0; ct < 2; ++ct) {
                        const int q8 = ct * 4 + (l16 >> 2);
#pragma unroll
                        for (int mt = 0; mt < 4; ++mt) {
#pragma unroll
                            for (int rr = 0; rr < 4; ++rr) {
                                const int c = c0 + mt * 16 + quad * 4 + rr;
                                s[ct][mt][rr] = (16 * c + 31 <= tq[ct]) ? fast_exp2(s[ct][mt][rr] * LOG2E - m[ct]) * invl[ct] : 0.f;
                            }
                            float gs = (s[ct][mt][0] + s[ct][mt][1]) + (s[ct][mt][2] + s[ct][mt][3]);
                            float es = s[ct][mt][3];
                            gs += __int_as_float(__builtin_amdgcn_update_dpp(0, __float_as_int(gs), 0xB1, 0xf, 0xf, false));
                            gs += __int_as_float(__builtin_amdgcn_update_dpp(0, __float_as_int(gs), 0x4E, 0xf, 0xf, false));
                            es += __int_as_float(__builtin_amdgcn_update_dpp(0, __float_as_int(es), 0xB1, 0xf, 0xf, false));
                            es += __int_as_float(__builtin_amdgcn_update_dpp(0, __float_as_int(es), 0x4E, 0xf, 0xf, false));
                            if (r == 0) {
                                const int j = (c0 >> 2) + mt * 4 + quad;
                                imp[q8 * 128 + j] = gs;
                                impe[q8 * 128 + j] = es;
                            }
                        }
                    }
                } else {
                    float bias[2], mr[2], mn[2], ls[2];
#pragma unroll
                    for (int ct = 0; ct < 2; ++ct) {
                        bias[ct] = 0.f; ls[ct] = 0.f; (void)ls[ct];
                        if (is_slc) {
                            const int q8 = ct * 4 + (l16 >> 2);
                            const unsigned w = selw[q8 * 4 + (jt >> 5)];
                            bias[ct] = ((w >> (jt & 31)) & 1u) ? 0.f : NINF;
                        }
                    }
                    if (elem) {
#pragma unroll
                        for (int ct = 0; ct < 2; ++ct) {
                            mr[ct] = NINF;
#pragma unroll
                            for (int mt = 0; mt < 4; ++mt)
#pragma unroll
                                for (int rr = 0; rr < 4; ++rr) {
                                    float x = __builtin_fmaf(s[ct][mt][rr], LOG2E, bias[ct]);
                                    const int dist = tq[ct] - (jt * 64 + mt * 16 + quad * 4 + rr);
                                    x = (dist >= 0 && dist < wlim) ? x : NINF;
                                    s[ct][mt][rr] = x; mr[ct] = fmaxf(mr[ct], x);
                                }
                        }
#pragma unroll
                        for (int ct = 0; ct < 2; ++ct) mr[ct] = fmaxf(mr[ct], __shfl_xor(mr[ct], 16));
#pragma unroll
                        for (int ct = 0; ct < 2; ++ct) mr[ct] = fmaxf(mr[ct], __shfl_xor(mr[ct], 32));
                        bool need = false;
#pragma unroll
                        for (int ct = 0; ct < 2; ++ct) need = need || (fmaxf(m[ct], mr[ct]) - m[ct] > 8.0f);
                        const bool resc = __builtin_amdgcn_ballot_w64(need) != 0;
#pragma unroll
                        for (int ct = 0; ct < 2; ++ct) {
                            mn[ct] = resc ? fmaxf(m[ct], mr[ct]) : m[ct];
#pragma unroll
                            for (int mt = 0; mt < 4; ++mt)
#pragma unroll
                                for (int rr = 0; rr < 4; ++rr) { s[ct][mt][rr] = fast_exp2(s[ct][mt][rr] - mn[ct]); }
                        }
                    } else {
#pragma unroll
                        for (int ct = 0; ct < 2; ++ct) {
                            mr[ct] = fmaxf(fmaxf(s[ct][0][0], s[ct][0][1]), fmaxf(s[ct][0][2], s[ct][0][3]));
#pragma unroll
                            for (int mt = 1; mt < 4; ++mt) mr[ct] = fmaxf(mr[ct], fmaxf(fmaxf(s[ct][mt][0], s[ct][mt][1]), fmaxf(s[ct][mt][2], s[ct][mt][3])));
                        }
#pragma unroll
                        for (int ct = 0; ct < 2; ++ct) mr[ct] = fmaxf(mr[ct], __shfl_xor(mr[ct], 16));
#pragma unroll
                        for (int ct = 0; ct < 2; ++ct) mr[ct] = fmaxf(mr[ct], __shfl_xor(mr[ct], 32));
                        float cand[2];
                        bool need = false;
#pragma unroll
                        for (int ct = 0; ct < 2; ++ct) {
                            cand[ct] = fmaxf(m[ct], __builtin_fmaf(mr[ct], LOG2E, bias[ct]));
                            need = need || (cand[ct] - m[ct] > 8.0f);
                        }
                        const bool resc = __builtin_amdgcn_ballot_w64(need) != 0;
#pragma unroll
                        for (int ct = 0; ct < 2; ++ct) {
                            mn[ct] = resc ? cand[ct] : m[ct];
                            const float nb = bias[ct] - mn[ct];
#pragma unroll
                            for (int mt = 0; mt < 4; ++mt)
#pragma unroll
                                for (int rr = 0; rr < 4; ++rr) { s[ct][mt][rr] = fast_exp2(__builtin_fmaf(s[ct][mt][rr], LOG2E, nb)); }
                        }
                    }
                    float al[2];
#pragma unroll
                    for (int ct = 0; ct < 2; ++ct) {
                        al[ct] = fast_exp2(m[ct] - mn[ct]);
                        m[ct] = mn[ct];
                    }
                    if (__builtin_amdgcn_ballot_w64(al[0] != 1.0f || al[1] != 1.0f)) {
#pragma unroll
                        for (int ct = 0; ct < 2; ++ct)
#pragma unroll
                            for (int i = 0; i < 4; ++i) o[ct][i] *= al[ct];
#pragma unroll
                        for (int ct = 0; ct < 2; ++ct) lacc[ct] *= al[ct];
                    }
                }
#pragma unroll
                for (int kk = 0; kk < 2; ++kk) {
                    u32x4 pb[2];
#pragma unroll
                    for (int ct = 0; ct < 2; ++ct)
                        pb[ct] = (u32x4){pk_bf16(s[ct][2 * kk][0], s[ct][2 * kk][1]), pk_bf16(s[ct][2 * kk][2], s[ct][2 * kk][3]),
                                         pk_bf16(s[ct][2 * kk + 1][0], s[ct][2 * kk + 1][1]), pk_bf16(s[ct][2 * kk + 1][2], s[ct][2 * kk + 1][3])};
                    lacc[0] = mfma16(ones8, __builtin_bit_cast(bf16x8, pb[0]), lacc[0]);
                    lacc[1] = mfma16(ones8, __builtin_bit_cast(bf16x8, pb[1]), lacc[1]);
#pragma unroll
                    for (int dt = 0; dt < 4; ++dt) {
                        const bf16x8 va = *(const bf16x8*)(cV + (dt * 16 + l16) * 128 + (((quad * 2 + kk) ^ rsw) * 16));
                        o[0][dt] = mfma16(va, __builtin_bit_cast(bf16x8, pb[0]), o[0][dt]);
                        o[1][dt] = mfma16(va, __builtin_bit_cast(bf16x8, pb[1]), o[1][dt]);
                    }
                }
            }
        }
    };
    {
        int n = 0;
#pragma unroll 1
        for (; n < n1; ++n) body(std::integral_constant<int, 0>{}, n);
        trans(n1);
#pragma unroll 1
        for (; n < n2; ++n) body(std::integral_constant<int, 1>{}, n);
        if (n2 != n1) trans(n2);
#pragma unroll 1
        for (; n < n3 - 1; ++n) body(std::integral_constant<int, 2>{}, n);
        body(std::integral_constant<int, 4>{}, n); ++n;
        trans(n3);
#pragma unroll 1
        for (; n < ntot; ++n) body(std::integral_constant<int, 3>{}, n);
    }
    finalize(g_win, true);
#pragma unroll
    for (int ct = 0; ct < 2; ++ct) {
        bf16_t* cat = (bf16_t*)(ws + OFF_CAT) + ((size_t)b * S_ + tq[ct]) * 1024 + 256 + (g * 4 + r) * 64 + quad * 4;
#pragma unroll
        for (int dt = 0; dt < 4; ++dt) {
            u32x2 pk; pk.x = pk_bf16(outacc[ct][dt][0], outacc[ct][dt][1]); pk.y = pk_bf16(outacc[ct][dt][2], outacc[ct][dt][3]);
            *(u32x2*)(cat + dt * 16) = pk;
        }
    }
    __syncthreads();
}

DEVI void phase_m3(const Params& p, int l, unsigned char* smem) {
    const int G = gridDim.x, bid = blockIdx.x;
    if ((G & 7) == 0) {
        const int x = bid & 7, bg = x & 3, nb = G >> 3, lb = (bid >> 3) + nb * (x >> 2);
        for (int pi = lb; pi < 128; pi += 2 * nb) {
            attn_item(p, bg, (255 - pi) * 32, smem);
            attn_item(p, bg, pi * 32, smem);
        }
    } else {
        for (int item = bid; item < 1024; item += G) attn_item(p, item & 3, (item >> 2) * 32, smem);
    }
    for (int i = bid; i < 1024; i += G) {
        const int wv = wave_();
        int wi = i * 4 + wv;
        if (i >= 512) { const int k = (wi >> 4) & 127; wi = (wi & ~(127 << 4)) | ((127 - k) << 4); }
        __syncthreads();
        s5_pass_b(p, l, wi, smem + wv * 16384);
    }
}

DEVI void phase_glu(const Params& p, int l, bf16_t* smem) {
    unsigned char* ws = p.ws;
    const bf16_t* A = (const bf16_t*)(ws + OFF_YG);
    const bf16_t* Bt = (const bf16_t*)(ws + OFF_W + (size_t)l * SZ_LAYER + OL_GLUT);
    bf16_t* cat = (bf16_t*)(ws + OFF_CAT);
    const float* gb = p.glu_b + l * 256;
    const int lane = TIDX & 63, wave = wave_(), wr = wave >> 1, wc = wave & 1, l16 = lane & 15, quad = lane >> 4;
    for (int it = 0;; ++it) {
        int tm, tn; if (!tile_map(it, 2, tm, tn)) break;
        f32x4 acc[4][4];
        const bf16_t* Ab = A + (size_t)tm * 128 * 256;
        gemm_tile<true>(acc, [&](int r) { return Ab + (size_t)r * 256; }, 64, Bt + (size_t)tn * 128 * 256, 256, smem);
#pragma unroll
        for (int mi = 0; mi < 4; ++mi)
#pragma unroll
            for (int ni = 0; ni < 4; ++ni) {
                const int row = tm * 128 + wr * 64 + mi * 16 + l16, col = tn * 128 + wc * 64 + ni * 16 + quad * 4;
                const u32x2 yb = *(const u32x2*)(A + (size_t)row * 256 + col);
                const f32x4 gb4 = *(const f32x4*)(gb + col);
                float o[4];
                o[0] = __uint_as_float(yb.x << 16) * sigmoidf_(acc[mi][ni][0] + gb4[0]);
                o[1] = __uint_as_float(yb.x & 0xffff0000u) * sigmoidf_(acc[mi][ni][1] + gb4[1]);
                o[2] = __uint_as_float(yb.y << 16) * sigmoidf_(acc[mi][ni][2] + gb4[2]);
                o[3] = __uint_as_float(yb.y & 0xffff0000u) * sigmoidf_(acc[mi][ni][3] + gb4[3]);
                u32x2 pk; pk.x = pk_bf16(o[0], o[1]); pk.y = pk_bf16(o[2], o[3]);
                *(u32x2*)(cat + (size_t)row * 1024 + 768 + col) = pk;
            }
    }
}


#define XB_TMO      128
#define XB_XCNT(j)  (256  + 64 * (j))
#define XB_XSUB(j)  (1280 + 64 * (j))
#define XB_XGEN(j)  (2304 + 64 * (j))
#define XB_TOP      3328
#define XB_TOPGEN   3392
#define XCD_BAR_WORDS 3456
#define XB_SPIN_CAP (1u << 20)
DEVI unsigned xb_ld(unsigned* p) { return __hip_atomic_load(p, __ATOMIC_RELAXED, __HIP_MEMORY_SCOPE_AGENT); }
DEVI unsigned xb_add(unsigned* p, unsigned v) { return __hip_atomic_fetch_add(p, v, __ATOMIC_RELAXED, __HIP_MEMORY_SCOPE_AGENT); }
DEVI unsigned xb_xcc_id() { return (unsigned)__builtin_amdgcn_s_getreg((3 << 11) | 20) & 0xFu; }
#define XB_SPIN(cond, bar) do { unsigned _sp = 0; while (cond) { __builtin_amdgcn_s_sleep(1); \
    if ((++_sp & 255u) == 0u) { if (xb_ld(&(bar)[XB_TMO])) break; if (_sp > XB_SPIN_CAP) { atomicAdd(&(bar)[XB_TMO], 1u); break; } } } } while (0)
struct XcdBarrier { unsigned* bar; unsigned x; volatile LAS unsigned* st; };
DEVI XcdBarrier xcd_barrier_post(unsigned* bar, volatile LAS unsigned* st) {
    XcdBarrier b; b.bar = bar; b.x = xb_xcc_id(); b.st = st;
    if (threadIdx.x == 0) (void)xb_add(&bar[XB_XCNT(b.x)], 1u);
    return b;
}
DEVI void xcd_barrier_complete(unsigned* bar, unsigned x, unsigned& nloc, unsigned& nx) {
    const unsigned G = gridDim.x * gridDim.y * gridDim.z;
    unsigned sum, cnt, mine, sp = 0u;
    for (;;) {
        sum = 0u; cnt = 0u; mine = 0u;
#pragma unroll
        for (unsigned j = 0; j < 16; ++j) { const unsigned c = xb_ld(&bar[XB_XCNT(j)]); sum += c; cnt += (c > 0u) ? 1u : 0u; mine = (j == x) ? c : mine; }
        if (sum == G) break;
        __builtin_amdgcn_s_sleep(1);
        if ((++sp & 255u) == 0u) { if (xb_ld(&bar[XB_TMO])) break; if (sp > XB_SPIN_CAP) { atomicAdd(&bar[XB_TMO], 1u); break; } }
    }
    nloc = mine > 0u ? mine : 1u; nx = cnt > 0u ? cnt : 1u;
}
DEVI void xcd_barrier(const XcdBarrier& b) {
    asm volatile("s_waitcnt vmcnt(0)" ::: "memory");
    __syncthreads();
    if (threadIdx.x == 0) {
        unsigned* bar = b.bar;
        __builtin_amdgcn_s_waitcnt(0);
        unsigned nloc = b.st[0], nx = b.st[1];
        if (nloc == 0u) { xcd_barrier_complete(bar, b.x, nloc, nx); b.st[0] = nloc; b.st[1] = nx; }
        const unsigned old = xb_add(&bar[XB_XSUB(b.x)], 1u);
        const unsigned gen = old / nloc;
        if (old + 1u == (gen + 1u) * nloc) {
            __builtin_amdgcn_fence(__ATOMIC_RELEASE, "agent");
            asm volatile("s_waitcnt vmcnt(0)" ::: "memory");
            const unsigned og = xb_add(&bar[XB_TOP], 1u);
            const unsigned tg = og / nx;
            if (og + 1u == (tg + 1u) * nx) xb_add(&bar[XB_TOPGEN], 1u);
            else XB_SPIN(xb_ld(&bar[XB_TOPGEN]) == tg, bar);
            __builtin_amdgcn_fence(__ATOMIC_ACQUIRE, "agent");
            xb_add(&bar[XB_XGEN(b.x)], 1u);
            asm volatile("s_waitcnt vmcnt(0)" ::: "memory");
        } else {
            XB_SPIN(xb_ld(&bar[XB_XGEN(b.x)]) == gen, bar);
            __builtin_amdgcn_fence(__ATOMIC_ACQUIRE, "agent");
            asm volatile("s_waitcnt vmcnt(0)" ::: "memory");
        }
    }
    __syncthreads();
}

constexpr int NSUB = 13;
constexpr int NPHASE = 1 + 4 * NSUB;

#ifndef ONLY_SUB
#define ONLY_SUB -1
#endif
#define EN(n) (ONLY_SUB < 0 || ONLY_SUB == (n))
DEVI void run_phase(const Params& p0, int ph, unsigned char* smem) {
    Params p = p0;
    { size_t z = 0; asm volatile("" : "+s"(z)); p.ws = p0.ws + z; }
    if (ph == 0) { if (EN(100)) phase_prologue(p, smem); return; }
    const int l = (ph - 1) / NSUB, sub = (ph - 1) % NSUB;
    unsigned char* ws = p.ws;
    const bf16_t* lw = (const bf16_t*)(ws + OFF_W + (size_t)l * SZ_LAYER);
    switch (sub) {
        case 0: case 10: if (EN(0)) phase_ffn_in(p, l, sub == 10, (bf16_t*)smem); break;
        case 1: case 11: if (EN(1)) {
            const float* res = (l == 0 && sub == 1) ? p.x : nullptr;
            const int lnidx = sub == 1 ? (l > 0 ? (l - 1) * 3 + 2 : 0) : l * 3 + 1;
            const bf16_t* Bt = (const bf16_t*)((const unsigned char*)lw + (sub == 11 ? OL_W2T1 : OL_W2T0));
            phase_gemm_res(p, (const bf16_t*)(ws + OFF_ACT), DFF, Bt, res, lnidx, 0.5f, (bf16_t*)smem);
        } break;
        case 2: case 9: case 12: if (EN(2)) phase_ln(p, l, sub == 2 ? 0 : (sub == 9 ? 1 : 2), l == 3 && sub == 12); break;
        case 3: if (EN(3)) phase_inproj(p, l, (bf16_t*)smem); break;
        case 4: if (EN(4)) phase_m2(p, l, smem); break;
        case 5: if (EN(5)) phase_m2b(p, l, smem); break;
        case 6: if (EN(6)) phase_m3(p, l, smem); break;
        case 7: if (EN(7)) phase_glu(p, l, (bf16_t*)smem); break;
        case 8: if (EN(8)) phase_gemm_res(p, (const bf16_t*)(ws + OFF_CAT), 1024, (const bf16_t*)((const unsigned char*)lw + OL_WOUTT), nullptr, l * 3 + 0, 1.0f, (bf16_t*)smem); break;
    }
}

__global__ void __launch_bounds__(256, 2) mega(Params p, int ph_lo, int ph_hi) {
    __shared__ __attribute__((aligned(16))) unsigned char smem[SMEM_BYTES];
    __shared__ u32x4 xbw;
    if (threadIdx.x == 0) xbw = (u32x4){0u, 0u, 0u, 0u};
    __syncthreads();
    XcdBarrier xb = xcd_barrier_post((unsigned*)(p.ws + OFF_BAR), (volatile LAS unsigned*)&xbw);
    for (int ph = ph_lo; ph < ph_hi; ++ph) {
#ifdef PROBE_DUP
        {
            const int sub = ph == 0 ? 100 : (ph - 1) % NSUB;
            if (sub == PROBE_DUP || (PROBE_DUP == 0 && sub == 10)) { run_phase(p, ph, smem); xcd_barrier(xb); }
        }
#endif
        run_phase(p, ph, smem);
        if (ph + 1 < ph_hi) {
            if (ph_hi < 0) cg::this_grid().sync();
            xcd_barrier(xb);
        }
    }
}

extern "C" void kernel_launch(void* const* d_in, const int* in_sizes, int n_in, void* d_out, int out_size, void* d_ws, size_t ws_size,
                              hipStream_t stream) {
    Params p{};
    const float** pp = (const float**)&p;
    for (int i = 0; i < 27; ++i) pp[i] = (const float*)d_in[i];
    p.out = (float*)d_out;
    p.ws = (unsigned char*)d_ws;
    if (ws_size < WS_TOTAL) fprintf(stderr, "workspace too small: %zu < %zu\n", ws_size, (size_t)WS_TOTAL);
    static int grid_blocks = 0;
    if (!grid_blocks) {
        int dev = 0, cus = 0, per_cu = 0;
        hipGetDevice(&dev);
        hipDeviceGetAttribute(&cus, hipDeviceAttributeMultiprocessorCount, dev);
        hipOccupancyMaxActiveBlocksPerMultiprocessor(&per_cu, mega, 256, 0);
        if (per_cu < 1) per_cu = 1;
        if (per_cu > 2) per_cu = 2;
        grid_blocks = cus * per_cu;
    }
#if MULTI
    for (int ph = 0; ph < NPHASE; ++ph) {
        hipLaunchKernelGGL(mega, dim3(grid_blocks), dim3(256), 0, stream, p, ph, ph + 1);
    }
#else
    (void)hipMemsetAsync((unsigned char*)d_ws + OFF_BAR, 0, BAR_BYTES, stream);
    int lo = 0, hi = NPHASE;
    void* args[] = {&p, &lo, &hi};
    hipError_t e = hipLaunchCooperativeKernel((void*)mega, dim3(grid_blocks), dim3(256), args, 0, stream);
    if (e != hipSuccess) fprintf(stderr, "cooperative launch failed: %s (grid %d)\n", hipGetErrorString(e), grid_blocks);
#endif
}
```
